# Optimizing an MI355X kernel written in HIP

```python
import jax, jax.numpy as jnp
from jax import lax
import numpy as np

D_MODEL = 2048
BATCH = 8
SEQ = 4096
DEPTH = 1

CHUNK = 64
N_MEM = 256
HG_WIDTH = D_MODEL // 2
HG_KDIM = 128
HG_HEADS = HG_WIDTH // HG_KDIM
HG_VDIM = HG_WIDTH // HG_HEADS
LRU_WIDTH = D_MODEL // 2
LRU_BLOCKS = 8
LRU_BLOCK = LRU_WIDTH // LRU_BLOCKS
CONV_WIDTH = 4
LRU_C = 8.0
XA_HEADS = 4
XA_HEAD_DIM = D_MODEL // XA_HEADS
D_FF = 256 * ((8 * D_MODEL // 3 + 255) // 256)
N_BRANCH = 2
IN_COLS = 4 * HG_WIDTH + 2 * LRU_WIDTH + N_BRANCH * D_MODEL
EPS = 1e-6

kernel_name = 'hybrid_hgrn2_rglru_gated_merge_macaron'


def rms_norm(x, g):
    xf = x.astype(jnp.float32)
    y = xf * lax.rsqrt(jnp.mean(xf * xf, axis=-1, keepdims=True) + EPS)
    return (y * g.astype(jnp.float32)).astype(x.dtype)


def swiglu(h, w_up, w_down):
    gate, up = jnp.split(h @ w_up, 2, axis=-1)
    return (jax.nn.silu(gate) * up) @ w_down


def hgrn2_chunked(q, f_logit, v, lb):
    B, S, H, K = q.shape
    V = v.shape[-1]
    nc = S // CHUNK
    qf = jax.nn.silu(q.astype(jnp.float32))
    f = lb + (1.0 - lb) * jax.nn.sigmoid(f_logit.astype(jnp.float32))
    log_f = jnp.log(f)
    k = 1.0 - f
    vf = v.astype(jnp.float32)

    def to_chunks(t):
        return t.reshape(B, nc, CHUNK, H, t.shape[-1]).transpose(1, 0, 3, 2, 4)

    tri = jnp.tril(jnp.ones((CHUNK, CHUNK), dtype=bool))

    def step(state, inp):
        qc, kc, vc, gc = inp
        b = jnp.cumsum(gc, axis=2)
        o_inter = jnp.einsum('bhtk,bhkv->bhtv', qc * jnp.exp(b), state)
        rel = b[:, :, :, None, :] - b[:, :, None, :, :]
        decay = jnp.where(tri[None, None, :, :, None], jnp.exp(jnp.minimum(rel, 0.0)), 0.0)
        scores = jnp.einsum('bhtk,bhsk,bhtsk->bhts', qc, kc, decay)
        o_intra = jnp.einsum('bhts,bhsv->bhtv', scores, vc)
        b_last = b[:, :, -1, :]
        k_dec = kc * jnp.exp(b_last[:, :, None, :] - b)
        state = jnp.exp(b_last)[..., None] * state + jnp.einsum('bhsk,bhsv->bhkv', k_dec, vc)
        return state, o_inter + o_intra

    state0 = jnp.zeros((B, H, K, V), jnp.float32)
    _, o = lax.scan(step, state0, (to_chunks(qf), to_chunks(k), to_chunks(vf), to_chunks(log_f)))
    return o.transpose(1, 0, 3, 2, 4).reshape(B, S, H, V)


def rglru_branch(xb, gate, conv_w, conv_b, wa, ba, wx, bx, lam):
    B, S, W = xb.shape
    xp = jnp.pad(xb, ((0, 0), (CONV_WIDTH - 1, 0), (0, 0)))
    xc = conv_b
    for j in range(CONV_WIDTH):
        xc = xc + xp[:, CONV_WIDTH - 1 - j:CONV_WIDTH - 1 - j + S, :] * conv_w[j]
    blocks = xc.reshape(B, S, LRU_BLOCKS, LRU_BLOCK)
    r = jax.nn.sigmoid((jnp.einsum('bsnh,nhk->bsnk', blocks, wa).reshape(B, S, W) + ba).astype(jnp.float32))
    i = jax.nn.sigmoid((jnp.einsum('bsnh,nhk->bsnk', blocks, wx).reshape(B, S, W) + bx).astype(jnp.float32))
    log_a = LRU_C * r * jax.nn.log_sigmoid(lam.astype(jnp.float32))
    a = jnp.exp(log_a)
    mult = jnp.sqrt(-jnp.expm1(2.0 * log_a))
    mult = jnp.where((jnp.arange(S) == 0)[None, :, None], 1.0, mult)
    u = xc.astype(jnp.float32) * i * mult

    def combine(c1, c2):
        a1, b1 = c1
        a2, b2 = c2
        return (a1 * a2, a2 * b1 + b2)

    _, h = lax.associative_scan(combine, (a, u), axis=1)
    return (h * jax.nn.gelu(gate.astype(jnp.float32))).astype(xb.dtype)


def cross_attention(h, m, wq, wkv, wo):
    B, S, D = h.shape
    M = m.shape[1]
    q = (h @ wq).reshape(B, S, XA_HEADS, XA_HEAD_DIM)
    k, v = jnp.split(m @ wkv, 2, axis=-1)
    k = k.reshape(B, M, XA_HEADS, XA_HEAD_DIM)
    v = v.reshape(B, M, XA_HEADS, XA_HEAD_DIM)
    s = jnp.einsum('bshd,bmhd->bhsm', q, k).astype(jnp.float32) * (XA_HEAD_DIM ** -0.5)
    p = jax.nn.softmax(s, axis=-1).astype(v.dtype)
    o = jnp.einsum('bhsm,bmhd->bshd', p, v).reshape(B, S, D)
    return o @ wo


def setup_inputs(seed: int = 0) -> dict:
    key = jax.random.key(seed)
    ks = jax.random.split(key, 32)
    f32 = jnp.float32

    def nrm(k, shape, fan_in):
        return jax.random.normal(k, shape, f32) * (fan_in ** -0.5)

    def gain(k, shape):
        return 1.0 + 0.05 * jax.random.normal(k, shape, f32)

    def bias(k, shape):
        return 0.01 * jax.random.normal(k, shape, f32)

    u = jax.random.uniform(ks[16], (DEPTH, LRU_WIDTH), f32, minval=0.9, maxval=0.999)
    p = u ** (1.0 / LRU_C)
    lam = jnp.log(p) - jnp.log1p(-p)
    return {
        'x': jax.random.normal(ks[0], (BATCH, SEQ, D_MODEL), f32),
        'mem': jax.random.normal(ks[1], (BATCH, N_MEM, D_MODEL), f32),
        'ffn1_norm': gain(ks[2], (DEPTH, D_MODEL)),
        'ffn1_w_up': nrm(ks[3], (DEPTH, D_MODEL, 2 * D_FF), D_MODEL),
        'ffn1_w_down': nrm(ks[4], (DEPTH, D_FF, D_MODEL), D_FF),
        'mix_norm': gain(ks[5], (DEPTH, D_MODEL)),
        'w_in': nrm(ks[6], (DEPTH, D_MODEL, IN_COLS), D_MODEL),
        'b_gate': bias(ks[7], (DEPTH, N_BRANCH, D_MODEL)),
        'hgrn_lb_logits': 0.5 * jax.random.normal(ks[8], (DEPTH + 1, HG_WIDTH), f32),
        'hgrn_norm': gain(ks[9], (DEPTH, HG_WIDTH)),
        'conv_w': 0.5 * jax.random.normal(ks[10], (DEPTH, CONV_WIDTH, LRU_WIDTH), f32),
        'conv_b': bias(ks[11], (DEPTH, LRU_WIDTH)),
        'lru_wa': nrm(ks[12], (DEPTH, LRU_BLOCKS, LRU_BLOCK, LRU_BLOCK), LRU_BLOCK),
        'lru_ba': bias(ks[13], (DEPTH, LRU_WIDTH)),
        'lru_wx': nrm(ks[14], (DEPTH, LRU_BLOCKS, LRU_BLOCK, LRU_BLOCK), LRU_BLOCK),
        'lru_bx': bias(ks[15], (DEPTH, LRU_WIDTH)),
        'lru_lambda': lam,
        'w_branch_a': nrm(ks[17], (DEPTH, HG_WIDTH, D_MODEL), HG_WIDTH),
        'w_branch_b': nrm(ks[18], (DEPTH, LRU_WIDTH, D_MODEL), LRU_WIDTH),
        'w_out': nrm(ks[19], (DEPTH, D_MODEL, D_MODEL), D_MODEL),
        'xattn_norm': gain(ks[20], (DEPTH, D_MODEL)),
        'mem_norm': gain(ks[21], (DEPTH, D_MODEL)),
        'xattn_wq': nrm(ks[22], (DEPTH, D_MODEL, D_MODEL), D_MODEL),
        'xattn_wkv': nrm(ks[23], (DEPTH, D_MODEL, 2 * D_MODEL), D_MODEL),
        'xattn_wo': nrm(ks[24], (DEPTH, D_MODEL, D_MODEL), D_MODEL),
        'ffn2_norm': gain(ks[25], (DEPTH, D_MODEL)),
        'ffn2_w_up': nrm(ks[26], (DEPTH, D_MODEL, 2 * D_FF), D_MODEL),
        'ffn2_w_down': nrm(ks[27], (DEPTH, D_FF, D_MODEL), D_FF),
        'final_norm': gain(ks[28], (D_MODEL,)),
    }


def reference(x, mem, ffn1_norm, ffn1_w_up, ffn1_w_down, mix_norm, w_in, b_gate,
              hgrn_lb_logits, hgrn_norm, conv_w, conv_b, lru_wa, lru_ba, lru_wx, lru_bx,
              lru_lambda, w_branch_a, w_branch_b, w_out, xattn_norm, mem_norm, xattn_wq,
              xattn_wkv, xattn_wo, ffn2_norm, ffn2_w_up, ffn2_w_down, final_norm):
    B, S, D = x.shape
    lb_table = jnp.cumsum(jax.nn.softmax(hgrn_lb_logits.astype(jnp.float32), axis=0), axis=0)
    splits = [HG_WIDTH, 2 * HG_WIDTH, 3 * HG_WIDTH, 4 * HG_WIDTH,
              4 * HG_WIDTH + LRU_WIDTH, 4 * HG_WIDTH + 2 * LRU_WIDTH]
    for l in range(DEPTH):
        x = x + 0.5 * swiglu(rms_norm(x, ffn1_norm[l]), ffn1_w_up[l], ffn1_w_down[l])

        h = rms_norm(x, mix_norm[l])
        proj = h @ w_in[l]
        q_a, f_a, i_a, g_a, x_b, gate_b, gates = jnp.split(proj, splits, axis=-1)

        lb = lb_table[l].reshape(HG_HEADS, HG_KDIM)
        o_a = hgrn2_chunked(q_a.reshape(B, S, HG_HEADS, HG_KDIM),
                            f_a.reshape(B, S, HG_HEADS, HG_KDIM),
                            i_a.reshape(B, S, HG_HEADS, HG_VDIM), lb)
        o_a = rms_norm(o_a, hgrn_norm[l].reshape(HG_HEADS, HG_VDIM))
        y_a = (o_a.reshape(B, S, HG_WIDTH) * jax.nn.silu(g_a.astype(jnp.float32))).astype(x.dtype)

        y_b = rglru_branch(x_b, gate_b, conv_w[l], conv_b[l], lru_wa[l], lru_ba[l],
                           lru_wx[l], lru_bx[l], lru_lambda[l])

        g = jax.nn.sigmoid(gates.reshape(B, S, N_BRANCH, D) + b_gate[l])
        merged = g[:, :, 0, :] * (y_a @ w_branch_a[l]) + g[:, :, 1, :] * (y_b @ w_branch_b[l])
        x = x + merged @ w_out[l]

        x = x + cross_attention(rms_norm(x, xattn_norm[l]), rms_norm(mem, mem_norm[l]),
                                xattn_wq[l], xattn_wkv[l], xattn_wo[l])

        x = x + 0.5 * swiglu(rms_norm(x, ffn2_norm[l]), ffn2_w_up[l], ffn2_w_down[l])
    return rms_norm(x, final_norm)
```

```cpp
#ifndef DBG_YB_SCALE
#define DBG_YB_SCALE 1.f
#endif
#include <hip/hip_runtime.h>
#include <hip/hip_cooperative_groups.h>
#include <cstdio>
#include <cstdint>
namespace cg = cooperative_groups;

#define LAS __attribute__((address_space(3)))
typedef unsigned short bf16_t;
typedef short bf16x8 __attribute__((ext_vector_type(8)));
typedef float f32x4 __attribute__((ext_vector_type(4)));
typedef unsigned u32x4 __attribute__((ext_vector_type(4)));
typedef unsigned u32x2 __attribute__((ext_vector_type(2)));

constexpr int T = 32768, D = 2048, DFF = 5632, NBATCH = 8, SEQ = 4096, HW = 1024, NMEM = 256, XH = 4, XD = 512;
constexpr float EPS = 1e-6f;
constexpr int NTHREADS = 512;
constexpr int STAGE_BYTES = 131072, LDS_BYTES = STAGE_BYTES + 16384;

constexpr size_t MiB = 1ull << 20;
constexpr size_t WS_CTL = 0;
constexpr size_t WS_W = 1 * MiB;
constexpr size_t E_WUP1 = 0, E_WDN1 = E_WUP1 + 23068672ull, E_WIN = E_WDN1 + 11534336ull, E_WAB = E_WIN + 20971520ull, E_WOUT = E_WAB + 4194304ull,
                 E_WQ = E_WOUT + 4194304ull, E_WKV = E_WQ + 4194304ull, E_WO = E_WKV + 8388608ull, E_WUP2 = E_WO + 4194304ull, E_WDN2 = E_WUP2 + 23068672ull,
                 E_WLA = E_WDN2 + 11534336ull, E_WLX = E_WLA + 131072ull, E_WEND = E_WLX + 131072ull;
static_assert(E_WEND * 2 <= 221 * MiB, "weights region");
constexpr size_t WS_XN = 222 * MiB;
constexpr size_t WS_YAB = 350 * MiB;
constexpr size_t WS_BIG = 478 * MiB;
constexpr size_t WS_HB = WS_BIG;
constexpr size_t WS_QS = WS_BIG, WS_KK = WS_BIG + 64 * MiB, WS_VV = WS_BIG + 128 * MiB, WS_GS = WS_BIG + 192 * MiB, WS_XB = WS_BIG + 256 * MiB,
                 WS_GB = WS_BIG + 320 * MiB, WS_LF = WS_BIG + 384 * MiB;
constexpr size_t WS_GAB = WS_BIG + 256 * MiB;
constexpr size_t WS_MG = WS_BIG;
constexpr size_t WS_Q = WS_BIG + 128 * MiB;
constexpr size_t WS_P = WS_BIG + 256 * MiB;
constexpr size_t WS_O = WS_BIG + 320 * MiB;
constexpr size_t WS_KMAT = WS_BIG + 512 * MiB;
constexpr size_t WS_VT = WS_BIG + 520 * MiB;
constexpr size_t WS_MEMN = WS_BIG + 528 * MiB;
constexpr size_t WS_END = WS_BIG + 536 * MiB;
static_assert(WS_END <= 1024 * MiB, "workspace");

typedef float f32x2_c __attribute__((ext_vector_type(2)));
typedef __bf16 bf16x2_c __attribute__((ext_vector_type(2)));
__device__ __forceinline__ unsigned cvt_pk_bf16(float lo, float hi) { f32x2_c v = {lo, hi}; bf16x2_c r = __builtin_convertvector(v, bf16x2_c); return __builtin_bit_cast(unsigned, r); }
__device__ __forceinline__ bf16_t f2bf(float f) { return (bf16_t)(cvt_pk_bf16(f, 0.f) & 0xffffu); }
__device__ __forceinline__ float bf2f(bf16_t b) { return __uint_as_float(((unsigned)b) << 16); }
__device__ __forceinline__ float bflo(unsigned w) { return __uint_as_float(w << 16); }
__device__ __forceinline__ float bfhi(unsigned w) { return __uint_as_float(w & 0xffff0000u); }
__device__ __forceinline__ float sigm(float x) { return __builtin_amdgcn_rcpf(1.f + __expf(-x)); }
__device__ __forceinline__ float siluf(float x) { return x * sigm(x); }
__device__ __forceinline__ float gelu_tanh(float x) { return x * sigm(1.5957691216f * (x + 0.044715f * x * x * x)); }
__device__ __forceinline__ float wave_sum(float v) {
#pragma unroll
    for (int o = 1; o < 64; o <<= 1) v += __shfl_xor(v, o);
    return v;
}
#define LDS_WAIT() asm volatile("s_waitcnt lgkmcnt(0)" ::: "memory")

namespace pg8 {
constexpr int BM = 256, BK = 64, HALF = 128, HTB = HALF * BK * 2, NXCD = 8, WGM = 8;
__host__ __device__ __forceinline__ int lds_byte(int r, int c) { const int st = (r >> 4) * 2 + (c >> 5), rr = r & 15, cc = c & 31, ob = rr * 64 + cc * 2; return st * 1024 + (ob ^ (((ob >> 9) & 1) << 5)); }
__host__ __device__ __forceinline__ void stage_rc(int b, int& R, int& C) { const int st = b / 1024, sb = b % 1024, swz = sb ^ (((sb >> 9) & 1) << 5); R = (st >> 1) * 16 + swz / 64; C = (st & 1) * 32 + (swz % 64) / 2; }
__host__ __device__ __forceinline__ int perm32(int rho) { const int n = rho >> 4, i = rho & 15; return 8 * (i >> 2) + 4 * n + (i & 3); }

struct Unit { int pm, pn; size_t aoff, boff, ooff; };

struct StdOrder {
    int nM, nN, nwg, G, c; size_t ta, tb, ldc; int ocols;
    __device__ void init(int M, int N, int G_, int c_, int lda, int ldb, int ldc_, int ocols_) { nM = M / BM; nN = N / BM; nwg = nM * nN; G = G_; c = c_; ta = (size_t)BM * lda * 2; tb = (size_t)BM * ldb * 2; ldc = (size_t)ldc_; ocols = ocols_; }
    __device__ bool next(int i, Unit& u) const {
        const long L = (long)i * G + c; if (L >= nwg) return false;
        int wgid = (int)L; { const int q = nwg / NXCD, r = nwg % NXCD, xcd = wgid % NXCD, off = wgid / NXCD; wgid = (xcd < r ? xcd * (q + 1) : r * (q + 1) + (xcd - r) * q) + off; }
        const int nig = WGM * nN, gid = wgid / nig, fm = gid * WGM, gsz = (nM - fm) < WGM ? (nM - fm) : WGM;
        u.pm = fm + ((wgid % nig) % gsz); u.pn = (wgid % nig) / gsz;
        u.aoff = (size_t)u.pm * ta; u.boff = (size_t)u.pn * tb; u.ooff = (size_t)u.pm * BM * ldc + (size_t)u.pn * ocols; return true;
    }
};
struct ScoreOrder {
    int G, c;
    __device__ bool next(int i, Unit& u) const {
        const int L = i * G + c; if (L >= NBATCH * XH * 16) return false;
        const int qt = L & 15, h = (L >> 4) & 3, b = L >> 6;
        u.pm = L; u.pn = 0;
        u.aoff = ((size_t)(b * SEQ + qt * 256) * D + (size_t)h * XD) * 2; u.boff = ((size_t)(b * NMEM) * D + (size_t)h * XD) * 2; u.ooff = (size_t)L * 65536; return true;
    }
};
struct PvOrder {
    int G, c;
    __device__ bool next(int i, Unit& u) const {
        const int L = i * G + c; if (L >= NBATCH * XH * 16 * 2) return false;
        const int nh = L & 1, U = L >> 1, qt = U & 15, h = (U >> 4) & 3, b = U >> 6;
        u.pm = U; u.pn = nh;
        u.aoff = (size_t)U * 65536 * 2; u.boff = ((size_t)(h * XD + nh * 256) * D + (size_t)b * NMEM) * 2;
        u.ooff = (size_t)(b * SEQ + qt * 256) * D + (size_t)(h * XD + nh * 256); return true;
    }
};

template <class Epi, class Sched, bool ALIGN_EPI = true, bool SP2 = true>
__device__ __forceinline__ void gemm_phase(LAS unsigned char* lds, const bf16_t* Ag, const bf16_t* Btg, const int K, const int lda, const int ldb, const Sched& S, const Epi& E) {
    const int tid = threadIdx.x, wid = __builtin_amdgcn_readfirstlane(tid >> 6), lane = tid & 63, wr = wid >> 2, wc = wid & 3, fr = lane & 15, fq = lane >> 4;
    const int nt = K / BK;
    unsigned voffA[2], voffB[2];
#pragma unroll
    for (int i = 0; i < 2; ++i) { int R, C; stage_rc(tid * 16 + i * 8192, R, C); const int Rb = Epi::PERM ? ((R & ~31) + perm32(R & 31)) : R;
        voffA[i] = (unsigned)(R * lda + C) * 2u; voffB[i] = (unsigned)(Rb * ldb + C) * 2u; }
    const size_t kstep = (size_t)(BK * 2);
    const size_t hstepA = (size_t)HALF * lda * 2, hstepB = (size_t)HALF * ldb * 2;
    const unsigned ldsw = (unsigned)wid * 1024u;
    const int aoff = lds_byte(wr * 64 + fr, fq * 8), boff = lds_byte(wc * 32 + fr, fq * 8);
#define PG8_SA(b, h) (((b) * 2 + (h)) * HTB)
#define PG8_SB(b, h) ((4 + (b) * 2 + (h)) * HTB)
#define PG8_STAGE(bufoff, gbase, voff) do { _Pragma("unroll") for (int _i = 0; _i < 2; ++_i) \
        __builtin_amdgcn_global_load_lds((const unsigned*)((const char*)(gbase) + (voff)[_i]), (LAS unsigned*)(lds + (bufoff) + ldsw + _i * 8192), 16, 0, 0); } while (0)
#define PG8_LDA(dst, b, h) do { _Pragma("unroll") for (int m = 0; m < 4; ++m) _Pragma("unroll") for (int k = 0; k < 2; ++k) dst[m][k] = *(const LAS bf16x8*)(lds + PG8_SA(b, h) + aoff + m * 2048 + k * 1024); } while (0)
#define PG8_LDB(dst, b, h) do { _Pragma("unroll") for (int n = 0; n < 2; ++n) _Pragma("unroll") for (int k = 0; k < 2; ++k) dst[n][k] = *(const LAS bf16x8*)(lds + PG8_SB(b, h) + boff + n * 2048 + k * 1024); } while (0)
#define PG8_MMA(ai, bj, At, Bt) do { __builtin_amdgcn_s_setprio(1); _Pragma("unroll") for (int m = 0; m < 4; ++m) _Pragma("unroll") for (int n = 0; n < 2; ++n) _Pragma("unroll") for (int k = 0; k < 2; ++k) \
        acc[ai][bj][m][n] = __builtin_amdgcn_mfma_f32_16x16x32_bf16(Bt[n][k], At[m][k], acc[ai][bj][m][n], 0, 0, 0); __builtin_amdgcn_s_setprio(0); } while (0)
#define PG8_WAIT_V(n) asm volatile("s_waitcnt vmcnt(" #n ")" ::: "memory")
#define PG8_WAIT_L(n) asm volatile("s_waitcnt lgkmcnt(" #n ")" ::: "memory")
#define PG8_BAR __builtin_amdgcn_s_barrier()
#define PG8_SCHED __builtin_amdgcn_sched_barrier(0)
    Unit cur, nxt; int ui = 0;
    if (!S.next(0, cur)) return;
    f32x4 acc[2][2][4][2];
#pragma unroll
    for (int a = 0; a < 2; ++a)
#pragma unroll
        for (int b = 0; b < 2; ++b)
#pragma unroll
            for (int m = 0; m < 4; ++m)
#pragma unroll
                for (int n = 0; n < 2; ++n) acc[a][b][m][n] = (f32x4){0.f, 0.f, 0.f, 0.f};
    bf16x8 At[4][2], B0[2][2], B1[2][2];
    const char* cA = (const char*)Ag + cur.aoff; const char* cB = (const char*)Btg + cur.boff;
    if constexpr (SP2) {
        PG8_STAGE(PG8_SB(0, 0), cB, voffB); PG8_STAGE(PG8_SB(0, 1), cB + hstepB, voffB); PG8_STAGE(PG8_SA(0, 0), cA, voffA); PG8_STAGE(PG8_SA(0, 1), cA + hstepA, voffA);
        if (wr == 1) PG8_BAR;
        PG8_WAIT_V(2); PG8_BAR;
        PG8_STAGE(PG8_SB(1, 0), cB + kstep, voffB); PG8_STAGE(PG8_SA(1, 0), cA + kstep, voffA); PG8_STAGE(PG8_SB(1, 1), cB + hstepB + kstep, voffB);
        PG8_WAIT_V(6); PG8_BAR;
    } else {
    PG8_STAGE(PG8_SB(0, 0), cB, voffB); PG8_STAGE(PG8_SA(0, 0), cA, voffA); PG8_STAGE(PG8_SB(0, 1), cB + hstepB, voffB); PG8_STAGE(PG8_SA(0, 1), cA + hstepA, voffA);
    if (wr == 1) PG8_BAR;
    PG8_WAIT_V(4); PG8_BAR;
    PG8_STAGE(PG8_SB(1, 0), cB + kstep, voffB); PG8_STAGE(PG8_SA(1, 0), cA + kstep, voffA); PG8_STAGE(PG8_SB(1, 1), cB + hstepB + kstep, voffB);
    PG8_WAIT_V(6); PG8_BAR;
    }
    for (;;) {
        const bool has_next = S.next(ui + 1, nxt);
        const char* nA = has_next ? (const char*)Ag + nxt.aoff : cA; const char* nB = has_next ? (const char*)Btg + nxt.boff : cB;
        for (int t = 0; t < nt; t += 2) {
            const bool last = (t == nt - 2);
            const char* a1 = cA + (size_t)(t + 1) * kstep;
            const char* a2 = last ? nA : cA + (size_t)(t + 2) * kstep; const char* b2 = last ? nB : cB + (size_t)(t + 2) * kstep;
            const char* a3 = a2 + kstep; const char* b3 = b2 + kstep;
            if constexpr (SP2) {
            PG8_LDB(B0, 0, 0); PG8_LDB(B1, 0, 1); PG8_SCHED; PG8_LDA(At, 0, 0); PG8_STAGE(PG8_SA(1, 1), a1 + hstepA, voffA);
            PG8_WAIT_V(8); PG8_WAIT_L(0); PG8_BAR; PG8_MMA(0, 0, At, B0); PG8_MMA(0, 1, At, B1); PG8_BAR; PG8_SCHED;
            PG8_LDA(At, 0, 1); PG8_STAGE(PG8_SB(0, 0), b2, voffB); PG8_STAGE(PG8_SB(0, 1), b2 + hstepB, voffB); PG8_STAGE(PG8_SA(0, 0), a2, voffA);
            PG8_WAIT_V(8); PG8_WAIT_L(0); PG8_BAR; PG8_MMA(1, 0, At, B0); PG8_MMA(1, 1, At, B1); PG8_BAR; PG8_SCHED;
            PG8_LDB(B0, 1, 0); PG8_LDB(B1, 1, 1); PG8_SCHED; PG8_LDA(At, 1, 0); PG8_STAGE(PG8_SA(0, 1), a2 + hstepA, voffA);
            PG8_WAIT_V(8); PG8_WAIT_L(0); PG8_BAR; PG8_MMA(0, 0, At, B0); PG8_MMA(0, 1, At, B1); PG8_BAR; PG8_SCHED;
            PG8_LDA(At, 1, 1); PG8_STAGE(PG8_SB(1, 0), b3, voffB); PG8_STAGE(PG8_SB(1, 1), b3 + hstepB, voffB); PG8_STAGE(PG8_SA(1, 0), a3, voffA);
            PG8_WAIT_V(8); PG8_WAIT_L(0); PG8_BAR; PG8_MMA(1, 0, At, B0); PG8_MMA(1, 1, At, B1); PG8_BAR; PG8_SCHED;
            } else {
            PG8_LDB(B0, 0, 0); PG8_SCHED; PG8_LDA(At, 0, 0); PG8_STAGE(PG8_SA(1, 1), a1 + hstepA, voffA);
            PG8_WAIT_L(8); PG8_BAR; PG8_WAIT_L(0); PG8_MMA(0, 0, At, B0); PG8_BAR; PG8_SCHED;
            PG8_LDB(B1, 0, 1); PG8_STAGE(PG8_SB(0, 0), b2, voffB);
            PG8_BAR; PG8_WAIT_L(0); PG8_MMA(0, 1, At, B1); PG8_BAR;
            PG8_LDA(At, 0, 1); PG8_STAGE(PG8_SA(0, 0), a2, voffA);
            PG8_BAR; PG8_WAIT_L(0); PG8_MMA(1, 0, At, B0); PG8_BAR; PG8_SCHED;
            PG8_STAGE(PG8_SB(0, 1), b2 + hstepB, voffB);
            PG8_WAIT_V(6); PG8_BAR; PG8_MMA(1, 1, At, B1); PG8_BAR;
            PG8_LDB(B0, 1, 0); PG8_SCHED; PG8_LDA(At, 1, 0); PG8_STAGE(PG8_SA(0, 1), a2 + hstepA, voffA);
            PG8_WAIT_L(8); PG8_BAR; PG8_WAIT_L(0); PG8_MMA(0, 0, At, B0); PG8_BAR; PG8_SCHED;
            PG8_LDB(B1, 1, 1); PG8_STAGE(PG8_SB(1, 0), b3, voffB);
            PG8_BAR; PG8_WAIT_L(0); PG8_MMA(0, 1, At, B1); PG8_BAR;
            PG8_LDA(At, 1, 1); PG8_STAGE(PG8_SA(1, 0), a3, voffA);
            PG8_BAR; PG8_WAIT_L(0); PG8_MMA(1, 0, At, B0); PG8_BAR; PG8_SCHED;
            PG8_STAGE(PG8_SB(1, 1), b3 + hstepB, voffB);
            PG8_WAIT_V(6); PG8_BAR; PG8_MMA(1, 1, At, B1); PG8_BAR;
            }
        }
        if constexpr (ALIGN_EPI) { if (wr == 0) PG8_BAR; }
        E(acc, cur, wr, wc, fr, fq);
        if (!has_next) break;
#pragma unroll
        for (int a = 0; a < 2; ++a)
#pragma unroll
            for (int b = 0; b < 2; ++b)
#pragma unroll
                for (int m = 0; m < 4; ++m)
#pragma unroll
                    for (int n = 0; n < 2; ++n) acc[a][b][m][n] = (f32x4){0.f, 0.f, 0.f, 0.f};
        cur = nxt; cA = nA; cB = nB; ++ui;
        if constexpr (ALIGN_EPI) { if (wr == 1) PG8_BAR; }
    }
    PG8_WAIT_V(0);
    if constexpr (!ALIGN_EPI) { if (wr == 0) PG8_BAR; }
    PG8_BAR;
#undef PG8_SA
#undef PG8_SB
#undef PG8_STAGE
#undef PG8_LDA
#undef PG8_LDB
#undef PG8_MMA
#undef PG8_WAIT_V
#undef PG8_WAIT_L
#undef PG8_BAR
#undef PG8_SCHED
}

typedef f32x4 Acc[2][2][4][2];
__device__ __forceinline__ u32x4 pack8(const f32x4 a, const f32x4 b) { u32x4 w; w.x = cvt_pk_bf16(a[0], a[1]); w.y = cvt_pk_bf16(a[2], a[3]); w.z = cvt_pk_bf16(b[0], b[1]); w.w = cvt_pk_bf16(b[2], b[3]); return w; }

struct EpiSwiGLU {
    static constexpr bool PERM = true, MIDK = false;
    bf16_t* H;
    __device__ __forceinline__ void operator()(Acc& acc, const Unit& u, int wr, int wc, int fr, int fq) const {
        bf16_t* base = H + u.ooff + (size_t)(wr * 64 + fr) * DFF + wc * 32 + 8 * fq;
#pragma unroll
        for (int ai = 0; ai < 2; ++ai)
#pragma unroll
            for (int m = 0; m < 4; ++m) {
                f32x4 h0, h1;
#pragma unroll
                for (int j = 0; j < 4; ++j) { h0[j] = siluf(acc[ai][0][m][0][j]) * acc[ai][1][m][0][j]; h1[j] = siluf(acc[ai][0][m][1][j]) * acc[ai][1][m][1][j]; }
                *(u32x4*)(base + (size_t)(ai * 128 + m * 16) * DFF) = pack8(h0, h1);
            }
    }
};
struct EpiResid {
    static constexpr bool PERM = true, MIDK = false;
    const float* R; float* O; float scale;
    __device__ __forceinline__ void operator()(Acc& acc, const Unit& u, int wr, int wc, int fr, int fq) const {
        const size_t p0 = u.ooff + (size_t)(wr * 64 + fr) * D + wc * 32 + 8 * fq;
#pragma unroll
        for (int ai = 0; ai < 2; ++ai)
#pragma unroll
            for (int m = 0; m < 4; ++m)
#pragma unroll
                for (int bj = 0; bj < 2; ++bj) {
                    const size_t p = p0 + (size_t)(ai * 128 + m * 16) * D + bj * 128;
                    const f32x4 r0 = *(const f32x4*)(R + p), r1 = *(const f32x4*)(R + p + 4);
                    *(f32x4*)(O + p) = r0 + acc[ai][bj][m][0] * scale; *(f32x4*)(O + p + 4) = r1 + acc[ai][bj][m][1] * scale;
                }
    }
};
struct EpiBf16 {
    static constexpr bool PERM = true, MIDK = false;
    bf16_t* O; int ldc; float scale;
    __device__ __forceinline__ void operator()(Acc& acc, const Unit& u, int wr, int wc, int fr, int fq) const {
        bf16_t* base = O + u.ooff + (size_t)(wr * 64 + fr) * ldc + wc * 32 + 8 * fq;
#pragma unroll
        for (int ai = 0; ai < 2; ++ai)
#pragma unroll
            for (int m = 0; m < 4; ++m)
#pragma unroll
                for (int bj = 0; bj < 2; ++bj)
                    *(u32x4*)(base + (size_t)(ai * 128 + m * 16) * ldc + bj * 128) = pack8(acc[ai][bj][m][0] * scale, acc[ai][bj][m][1] * scale);
    }
};
struct EpiWin {
    static constexpr bool PERM = true, MIDK = false;
    bf16_t *QS, *KK, *VV, *GS, *XB, *GB; float* LF; const float* LB;
    __device__ __forceinline__ void operator()(Acc& acc, const Unit& u, int wr, int wc, int fr, int fq) const {
        const int seg = u.pn >> 2;
        const int col0 = (u.pn & 3) * 256 + wc * 32 + 8 * fq;
        const size_t row0 = (size_t)u.pm * 256 + wr * 64 + fr;
        bf16_t* dst = seg == 0 ? QS : seg == 1 ? KK : seg == 2 ? VV : seg == 3 ? GS : seg == 4 ? XB : GB;
#pragma unroll
        for (int bj = 0; bj < 2; ++bj) {
            const int col = col0 + bj * 128;
            f32x4 lb0 = (f32x4){0.f, 0.f, 0.f, 0.f}, lb1 = lb0;
            if (seg == 1) { lb0 = *(const f32x4*)(LB + col); lb1 = *(const f32x4*)(LB + col + 4); }
#pragma unroll
            for (int ai = 0; ai < 2; ++ai)
#pragma unroll
                for (int m = 0; m < 4; ++m) {
                    const size_t p = (row0 + ai * 128 + m * 16) * HW + col;
                    f32x4 v0 = acc[ai][bj][m][0], v1 = acc[ai][bj][m][1];
                    if (seg == 0 || seg == 3) {
#pragma unroll
                        for (int j = 0; j < 4; ++j) { v0[j] = siluf(v0[j]); v1[j] = siluf(v1[j]); }
                    } else if (seg == 1) {
                        f32x4 l0, l1;
#pragma unroll
                        for (int j = 0; j < 4; ++j) {
                            const float s0 = sigm(v0[j]), s1 = sigm(v1[j]);
                            l0[j] = __logf(lb0[j] + (1.f - lb0[j]) * s0); l1[j] = __logf(lb1[j] + (1.f - lb1[j]) * s1);
                            v0[j] = (1.f - lb0[j]) * (1.f - s0); v1[j] = (1.f - lb1[j]) * (1.f - s1);
                        }
                        *(f32x4*)(LF + p) = l0; *(f32x4*)(LF + p + 4) = l1;
                    } else if (seg == 5) {
#pragma unroll
                        for (int j = 0; j < 4; ++j) { v0[j] = gelu_tanh(v0[j]); v1[j] = gelu_tanh(v1[j]); }
                    }
                    *(u32x4*)(dst + p) = pack8(v0, v1);
                }
        }
    }
};
struct EpiGates {
    static constexpr bool PERM = true, MIDK = false;
    bf16_t* GAB; const float* bg;
    __device__ __forceinline__ void operator()(Acc& acc, const Unit& u, int wr, int wc, int fr, int fq) const {
        const int col0 = u.pn * 256 + wc * 32 + 8 * fq;
        const size_t row0 = (size_t)u.pm * 256 + wr * 64 + fr;
#pragma unroll
        for (int bj = 0; bj < 2; ++bj) {
            const int col = col0 + bj * 128;
            const f32x4 b0 = *(const f32x4*)(bg + col), b1 = *(const f32x4*)(bg + col + 4);
#pragma unroll
            for (int ai = 0; ai < 2; ++ai)
#pragma unroll
                for (int m = 0; m < 4; ++m) {
                    f32x4 v0 = acc[ai][bj][m][0] + b0, v1 = acc[ai][bj][m][1] + b1;
#pragma unroll
                    for (int j = 0; j < 4; ++j) { v0[j] = sigm(v0[j]); v1[j] = sigm(v1[j]); }
                    *(u32x4*)(GAB + (row0 + ai * 128 + m * 16) * 4096 + col) = pack8(v0, v1);
                }
        }
    }
};
template <int PASS> struct EpiMerge {
    static constexpr bool PERM = true, MIDK = false;
    const bf16_t* GAB; bf16_t* MG;
    __device__ __forceinline__ void operator()(Acc& acc, const Unit& u, int wr, int wc, int fr, int fq) const {
        const int col0 = u.pn * 256 + wc * 32 + 8 * fq;
        const size_t row0 = (size_t)u.pm * 256 + wr * 64 + fr;
#pragma unroll
        for (int ai = 0; ai < 2; ++ai)
#pragma unroll
            for (int m = 0; m < 4; ++m)
#pragma unroll
                for (int bj = 0; bj < 2; ++bj) {
                    const size_t r = row0 + ai * 128 + m * 16; const int col = col0 + bj * 128;
                    const u32x4 b = *(const u32x4*)(GAB + r * 4096 + PASS * 2048 + col);
                    f32x4 v0 = acc[ai][bj][m][0], v1 = acc[ai][bj][m][1];
                    v0[0] *= bflo(b.x); v0[1] *= bfhi(b.x); v0[2] *= bflo(b.y); v0[3] *= bfhi(b.y);
                    v1[0] *= bflo(b.z); v1[1] *= bfhi(b.z); v1[2] *= bflo(b.w); v1[3] *= bfhi(b.w);
                    if (PASS == 1) {
                        const u32x4 p = *(const u32x4*)(MG + r * D + col);
                        v0[0] += bflo(p.x); v0[1] += bfhi(p.x); v0[2] += bflo(p.y); v0[3] += bfhi(p.y);
                        v1[0] += bflo(p.z); v1[1] += bfhi(p.z); v1[2] += bflo(p.w); v1[3] += bfhi(p.w);
                    }
                    *(u32x4*)(MG + r * D + col) = pack8(v0, v1);
                }
    }
};
struct EpiSoftmax {
    static constexpr bool PERM = true, MIDK = false;
    bf16_t* P; LAS float* SM; LAS float* SS;
    __device__ __forceinline__ void operator()(Acc& acc, const Unit& u, int wr, int wc, int fr, int fq) const {
        float mx[2][4];
#pragma unroll
        for (int ai = 0; ai < 2; ++ai)
#pragma unroll
            for (int m = 0; m < 4; ++m) {
                float v = -3.0e38f;
#pragma unroll
                for (int bj = 0; bj < 2; ++bj)
#pragma unroll
                    for (int n = 0; n < 2; ++n)
#pragma unroll
                        for (int j = 0; j < 4; ++j) v = fmaxf(v, acc[ai][bj][m][n][j]);
                v = fmaxf(v, __shfl_xor(v, 16)); v = fmaxf(v, __shfl_xor(v, 32));
                if (fq == 0) SM[(ai * 128 + wr * 64 + m * 16 + fr) * 4 + wc] = v;
            }
        LDS_WAIT(); __builtin_amdgcn_s_barrier(); asm volatile("" ::: "memory");
#pragma unroll
        for (int ai = 0; ai < 2; ++ai)
#pragma unroll
            for (int m = 0; m < 4; ++m) {
                const f32x4 q = *(const LAS f32x4*)(SM + (ai * 128 + wr * 64 + m * 16 + fr) * 4);
                const float M = fmaxf(fmaxf(q[0], q[1]), fmaxf(q[2], q[3]));
                float s = 0.f;
#pragma unroll
                for (int bj = 0; bj < 2; ++bj)
#pragma unroll
                    for (int n = 0; n < 2; ++n)
#pragma unroll
                        for (int j = 0; j < 4; ++j) { const float e = __expf(acc[ai][bj][m][n][j] - M); acc[ai][bj][m][n][j] = e; s += e; }
                s += __shfl_xor(s, 16); s += __shfl_xor(s, 32);
                if (fq == 0) SS[(ai * 128 + wr * 64 + m * 16 + fr) * 4 + wc] = s;
            }
        LDS_WAIT(); __builtin_amdgcn_s_barrier(); asm volatile("" ::: "memory");
        bf16_t* base = P + u.ooff + (size_t)(wr * 64 + fr) * 256 + wc * 32 + 8 * fq;
#pragma unroll
        for (int ai = 0; ai < 2; ++ai)
#pragma unroll
            for (int m = 0; m < 4; ++m) {
                const f32x4 q = *(const LAS f32x4*)(SS + (ai * 128 + wr * 64 + m * 16 + fr) * 4);
                const float inv = __builtin_amdgcn_rcpf((q[0] + q[1]) + (q[2] + q[3]));
#pragma unroll
                for (int bj = 0; bj < 2; ++bj)
                    *(u32x4*)(base + (size_t)(ai * 128 + m * 16) * 256 + bj * 128) = pack8(acc[ai][bj][m][0] * inv, acc[ai][bj][m][1] * inv);
            }
    }
};
}

struct Args {
    const float* in[29]; float* out; unsigned char* ws; int ph_lo, ph_hi;
};

__device__ __forceinline__ void tr_load(const float* W, int N, int k0, int n0, int lane, f32x4 (&r)[8]) {
#pragma unroll
    for (int i = 0; i < 8; ++i) r[i] = __builtin_nontemporal_load((const f32x4*)(W + (size_t)(k0 + 8 * i + (lane >> 3)) * N + n0 + 4 * (lane & 7)));
}
__device__ __forceinline__ void tr_store(const f32x4 (&r)[8], bf16_t* WT, int dstK, size_t drow0, int kdst0, int k0, LAS float* scr, int lane) {
#pragma unroll
    for (int i = 0; i < 8; ++i) { LAS float* d = scr + (8 * i + (lane >> 3)) * 33 + 4 * (lane & 7); d[0] = r[i][0]; d[1] = r[i][1]; d[2] = r[i][2]; d[3] = r[i][3]; }
    LDS_WAIT();
    const int c = lane & 7;
#pragma unroll
    for (int j = 0; j < 4; ++j) { const int n = (lane >> 3) + 8 * j; const LAS float* s = scr + (8 * c) * 33 + n;
        u32x4 o; o.x = cvt_pk_bf16(s[0 * 33], s[1 * 33]); o.y = cvt_pk_bf16(s[2 * 33], s[3 * 33]); o.z = cvt_pk_bf16(s[4 * 33], s[5 * 33]); o.w = cvt_pk_bf16(s[6 * 33], s[7 * 33]);
        *(u32x4*)(WT + (drow0 + n) * dstK + kdst0 + k0 + 8 * c) = o; }
    LDS_WAIT();
}
__device__ __forceinline__ size_t tr_drow(int n0, int mode) {
    if (mode == 1) { const int half = n0 >= DFF ? 1 : 0, nn = n0 - half * DFF; return (size_t)(nn >> 7) * 256 + half * 128 + (nn & 127); }
    return (size_t)n0;
}
__device__ __forceinline__ void transpose_matrix(const float* W, int K, int N, bf16_t* WT, int dstK, int kdst0, int mode, LAS float* scr, int gw, int NGW, int lane) {
    const int nblk = N / 32, items = (K / 64) * nblk;
    for (int it = gw; it < items; it += 2 * NGW) {
        const int it2 = it + NGW; const bool two = it2 < items;
        const int kb = it / nblk, nb = it % nblk, kb2 = two ? it2 / nblk : kb, nb2 = two ? it2 % nblk : nb;
        f32x4 ra[8], rb[8];
        tr_load(W, N, kb * 64, nb * 32, lane, ra);
        tr_load(W, N, kb2 * 64, nb2 * 32, lane, rb);
        tr_store(ra, WT, dstK, tr_drow(nb * 32, mode), kdst0, kb * 64, scr, lane);
        if (two) tr_store(rb, WT, dstK, tr_drow(nb2 * 32, mode), kdst0, kb2 * 64, scr, lane);
    }
}
__device__ __forceinline__ void rms_row_bf16(const float* xrow, const float* g, bf16_t* orow, int lane) {
    f32x4 v[8]; float s = 0.f;
#pragma unroll
    for (int j = 0; j < 8; ++j) { v[j] = __builtin_nontemporal_load((const f32x4*)xrow + lane + 64 * j); s += (v[j][0] * v[j][0] + v[j][1] * v[j][1]) + (v[j][2] * v[j][2] + v[j][3] * v[j][3]); }
    const float rstd = rsqrtf(wave_sum(s) * (1.f / D) + EPS);
#pragma unroll
    for (int j = 0; j < 8; ++j) { const f32x4 gg = ((const f32x4*)g)[lane + 64 * j]; u32x2 o; o.x = cvt_pk_bf16(v[j][0] * rstd * gg[0], v[j][1] * rstd * gg[1]); o.y = cvt_pk_bf16(v[j][2] * rstd * gg[2], v[j][3] * rstd * gg[3]);
        __builtin_nontemporal_store(o, (u32x2*)orow + lane + 64 * j); }
}
__device__ __forceinline__ void rms_row2_bf16(const float* xa, const float* xb, const float* g, bf16_t* oa, bf16_t* ob, int lane) {
    f32x4 va[8], vb[8]; float sa = 0.f, sb = 0.f;
#pragma unroll
    for (int j = 0; j < 8; ++j) { va[j] = __builtin_nontemporal_load((const f32x4*)xa + lane + 64 * j); vb[j] = __builtin_nontemporal_load((const f32x4*)xb + lane + 64 * j); }
#pragma unroll
    for (int j = 0; j < 8; ++j) { sa += (va[j][0] * va[j][0] + va[j][1] * va[j][1]) + (va[j][2] * va[j][2] + va[j][3] * va[j][3]); sb += (vb[j][0] * vb[j][0] + vb[j][1] * vb[j][1]) + (vb[j][2] * vb[j][2] + vb[j][3] * vb[j][3]); }
    const float ra = rsqrtf(wave_sum(sa) * (1.f / D) + EPS), rb = rsqrtf(wave_sum(sb) * (1.f / D) + EPS);
#pragma unroll
    for (int j = 0; j < 8; ++j) { const f32x4 gg = ((const f32x4*)g)[lane + 64 * j]; u32x2 o;
        o.x = cvt_pk_bf16(va[j][0] * ra * gg[0], va[j][1] * ra * gg[1]); o.y = cvt_pk_bf16(va[j][2] * ra * gg[2], va[j][3] * ra * gg[3]); __builtin_nontemporal_store(o, (u32x2*)oa + lane + 64 * j);
        o.x = cvt_pk_bf16(vb[j][0] * rb * gg[0], vb[j][1] * rb * gg[1]); o.y = cvt_pk_bf16(vb[j][2] * rb * gg[2], vb[j][3] * rb * gg[3]); __builtin_nontemporal_store(o, (u32x2*)ob + lane + 64 * j); }
}
__device__ __forceinline__ void norm_all_bf16(const float* src, const float* g, bf16_t* dst, int gw, int NGW, int lane) {
    int m = gw;
    for (; m + NGW < T; m += 2 * NGW) rms_row2_bf16(src + (size_t)m * D, src + (size_t)(m + NGW) * D, g, dst + (size_t)m * D, dst + (size_t)(m + NGW) * D, lane);
    for (; m < T; m += NGW) rms_row_bf16(src + (size_t)m * D, g, dst + (size_t)m * D, lane);
}
__device__ __forceinline__ void rms_row_f32(float* xrow, const float* g, int lane) {
    f32x4 v[8]; float s = 0.f;
#pragma unroll
    for (int j = 0; j < 8; ++j) { v[j] = __builtin_nontemporal_load((const f32x4*)xrow + lane + 64 * j); s += (v[j][0] * v[j][0] + v[j][1] * v[j][1]) + (v[j][2] * v[j][2] + v[j][3] * v[j][3]); }
    const float rstd = rsqrtf(wave_sum(s) * (1.f / D) + EPS);
#pragma unroll
    for (int j = 0; j < 8; ++j) { const f32x4 gg = ((const f32x4*)g)[lane + 64 * j]; __builtin_nontemporal_store(v[j] * rstd * gg, (f32x4*)xrow + lane + 64 * j); }
}

#define MFMA16(a, b, c) __builtin_amdgcn_mfma_f32_16x16x32_bf16((a), (b), (c), 0, 0, 0)
__device__ __forceinline__ void hgrn_item(LAS unsigned char* lds, int item, const bf16_t* QS, const float* LF, const bf16_t* KK, const bf16_t* VV, bf16_t* YAB) {
    const int tid = threadIdx.x, lane = tid & 63, wid = tid >> 6, l15 = lane & 15, quad = lane >> 4;
    const int b = item >> 4, h = (item >> 1) & 7, vh = item & 1;
    LAS bf16_t* QT = (LAS bf16_t*)(lds + 0);
    LAS bf16_t* KT = (LAS bf16_t*)(lds + 17408);
    LAS bf16_t* QH = (LAS bf16_t*)(lds + 34816);
    LAS bf16_t* KD = (LAS bf16_t*)(lds + 52224);
    LAS bf16_t* VT = (LAS bf16_t*)(lds + 70656);
    LAS bf16_t* PP = (LAS bf16_t*)(lds + 79872);
    LAS bf16_t* ST = (LAS bf16_t*)(lds + 89088);
    LAS float* DD = (LAS float*)(lds + 106496);
    LAS float* PS = (LAS float*)(lds + 107008);
    const int k = tid & 127, part = tid >> 7;
    const int vv = tid & 63, sg = tid >> 6;
    const size_t row0 = (size_t)b * SEQ;
    const int colq = h * 128 + k, colv = h * 128 + vh * 64 + vv;
    const int tt = wid >> 1, vt0 = (wid & 1) * 2;
    f32x4 S[4];
#pragma unroll
    for (int i = 0; i < 4; ++i) S[i] = (f32x4){0.f, 0.f, 0.f, 0.f};
    for (int i = tid; i < 64 * 136 / 2; i += NTHREADS) ((LAS unsigned*)ST)[i] = 0u;
    float lfv[16]; bf16_t qv[16], kv[16], vr[8];
#define HG_LOAD(c) do { const size_t r_ = row0 + (size_t)(c) * 64; \
        _Pragma("unroll") for (int i = 0; i < 16; ++i) { const size_t p_ = (r_ + part * 16 + i) * HW + colq; lfv[i] = LF[p_]; qv[i] = QS[p_]; kv[i] = KK[p_]; } \
        _Pragma("unroll") for (int i = 0; i < 8; ++i) vr[i] = VV[(r_ + sg * 8 + i) * HW + colv]; } while (0)
    HG_LOAD(0);
    for (int c = 0; c < 64; ++c) {
        float bl[16]; float run = 0.f;
#pragma unroll
        for (int i = 0; i < 16; ++i) { run += lfv[i]; bl[i] = run; }
        PS[part * 128 + k] = run;
        __syncthreads();
        const float p0 = PS[k], p1 = PS[128 + k], p2 = PS[256 + k], p3 = PS[384 + k];
        const float pre = part == 0 ? 0.f : part == 1 ? p0 : part == 2 ? p0 + p1 : p0 + p1 + p2;
        const float mref = p0 + p1, blast = (p0 + p1) + (p2 + p3);
        const float em = __expf(mref), ebm = __expf(blast - mref);
        float kd[16];
#pragma unroll
        for (int i = 0; i < 16; ++i) {
            const float bb = pre + bl[i];
            const float e1 = __expf(fminf(fmaxf(bb - mref, -80.f), 80.f)), e2 = __builtin_amdgcn_rcpf(e1);
            const float q = bf2f(qv[i]), kx = bf2f(kv[i]);
            const int s = part * 16 + i;
            QT[s * 136 + k] = f2bf(q * e1); KT[s * 136 + k] = f2bf(kx * e2); QH[s * 136 + k] = f2bf(q * e1 * em); kd[i] = kx * e2 * ebm;
        }
        { u32x4 w0, w1;
          w0.x = cvt_pk_bf16(kd[0], kd[1]); w0.y = cvt_pk_bf16(kd[2], kd[3]); w0.z = cvt_pk_bf16(kd[4], kd[5]); w0.w = cvt_pk_bf16(kd[6], kd[7]);
          w1.x = cvt_pk_bf16(kd[8], kd[9]); w1.y = cvt_pk_bf16(kd[10], kd[11]); w1.z = cvt_pk_bf16(kd[12], kd[13]); w1.w = cvt_pk_bf16(kd[14], kd[15]);
          *(LAS u32x4*)(KD + k * 72 + part * 16) = w0; *(LAS u32x4*)(KD + k * 72 + part * 16 + 8) = w1; }
        if (part == 0) DD[k] = em * ebm;
        { u32x4 w; w.x = (unsigned)vr[0] | ((unsigned)vr[1] << 16); w.y = (unsigned)vr[2] | ((unsigned)vr[3] << 16); w.z = (unsigned)vr[4] | ((unsigned)vr[5] << 16); w.w = (unsigned)vr[6] | ((unsigned)vr[7] << 16);
          *(LAS u32x4*)(VT + vv * 72 + sg * 8) = w; }
        __syncthreads();
        if (c + 1 < 64) HG_LOAD(c + 1);
        f32x4 acc_o[2];
        acc_o[0] = (f32x4){0.f, 0.f, 0.f, 0.f}; acc_o[1] = acc_o[0];
        {
            const int ti = wid >> 1;
#pragma unroll
            for (int q2 = 0; q2 < 2; ++q2) {
                const int si = (wid & 1) * 2 + q2;
                f32x4 a = (f32x4){0.f, 0.f, 0.f, 0.f};
                if (si <= ti) {
#pragma unroll
                    for (int ks = 0; ks < 4; ++ks) {
                        const bf16x8 af = *(const LAS bf16x8*)(QT + (ti * 16 + l15) * 136 + ks * 32 + quad * 8);
                        const bf16x8 bfr = *(const LAS bf16x8*)(KT + (si * 16 + l15) * 136 + ks * 32 + quad * 8);
                        a = MFMA16(af, bfr, a);
                    }
                }
#pragma unroll
                for (int j = 0; j < 4; ++j) { const int t = ti * 16 + quad * 4 + j, s = si * 16 + l15; PP[t * 72 + s] = f2bf((s <= t) ? a[j] : 0.f); }
            }
#pragma unroll
            for (int ks = 0; ks < 4; ++ks) {
                const bf16x8 af = *(const LAS bf16x8*)(QH + (tt * 16 + l15) * 136 + ks * 32 + quad * 8);
#pragma unroll
                for (int v2 = 0; v2 < 2; ++v2) {
                    const bf16x8 bfr = *(const LAS bf16x8*)(ST + ((vt0 + v2) * 16 + l15) * 136 + ks * 32 + quad * 8);
                    acc_o[v2] = MFMA16(af, bfr, acc_o[v2]);
                }
            }
        }
        __syncthreads();
#pragma unroll
        for (int ks = 0; ks < 2; ++ks) {
            const bf16x8 af = *(const LAS bf16x8*)(PP + (tt * 16 + l15) * 72 + ks * 32 + quad * 8);
#pragma unroll
            for (int v2 = 0; v2 < 2; ++v2) {
                const bf16x8 bfr = *(const LAS bf16x8*)(VT + ((vt0 + v2) * 16 + l15) * 72 + ks * 32 + quad * 8);
                acc_o[v2] = MFMA16(af, bfr, acc_o[v2]);
            }
        }
#pragma unroll
        for (int v2 = 0; v2 < 2; ++v2)
#pragma unroll
            for (int j = 0; j < 4; ++j) YAB[(row0 + (size_t)c * 64 + tt * 16 + quad * 4 + j) * D + h * 128 + vh * 64 + (vt0 + v2) * 16 + l15] = f2bf(acc_o[v2][j]);
        {
            const f32x4 dv = *(const LAS f32x4*)(DD + wid * 16 + quad * 4);
#pragma unroll
            for (int v4 = 0; v4 < 4; ++v4) S[v4] *= dv;
#pragma unroll
            for (int ks = 0; ks < 2; ++ks) {
                const bf16x8 af = *(const LAS bf16x8*)(KD + (wid * 16 + l15) * 72 + ks * 32 + quad * 8);
#pragma unroll
                for (int v4 = 0; v4 < 4; ++v4) {
                    const bf16x8 bfr = *(const LAS bf16x8*)(VT + (v4 * 16 + l15) * 72 + ks * 32 + quad * 8);
                    S[v4] = MFMA16(af, bfr, S[v4]);
                }
            }
#pragma unroll
            for (int v4 = 0; v4 < 4; ++v4) { u32x2 w; w.x = cvt_pk_bf16(S[v4][0], S[v4][1]); w.y = cvt_pk_bf16(S[v4][2], S[v4][3]); *(LAS u32x2*)(ST + (v4 * 16 + l15) * 136 + wid * 16 + quad * 4) = w; }
        }
    }
#undef HG_LOAD
    __syncthreads();
}

__device__ __forceinline__ void lru_item(LAS unsigned char* lds, int item, const bf16_t* XB, const bf16_t* GB, const float* conv_w, const float* conv_b, const bf16_t* WLA, const bf16_t* WLX,
                                         const float* ba, const float* bx, const float* lam, bf16_t* YAB) {
    const int tid = threadIdx.x, lane = tid & 63, wid = tid >> 6, l15 = lane & 15, quad = lane >> 4;
    const int b = item >> 4, n = (item >> 1) & 7, oh = item & 1;
    LAS bf16_t* XC = (LAS bf16_t*)(lds + 0);
    LAS bf16_t* WL = (LAS bf16_t*)(lds + 17408);
    LAS float* XCF = (LAS float*)(lds + 52224);
    LAS float* AA = XCF + 64 * 65;
    LAS float* UU = AA + 64 * 65;
    LAS float* GA = UU + 64 * 65;
    LAS float* GH = GA + 512;
    LAS float* HC = GH + 512;
    const int ch = tid & 127, part = tid >> 7;
    const int st = wid >> 1, ct0 = (wid & 1) * 2;
    const int cl = tid & 63, g = tid >> 6;
    const size_t row0 = (size_t)b * SEQ;
    const int colc = n * 128 + ch;
    const float w0 = conv_w[0 * HW + colc], w1 = conv_w[1 * HW + colc], w2 = conv_w[2 * HW + colc], w3 = conv_w[3 * HW + colc], cb = conv_b[colc];
    const bool own = (ch >> 6) == oh;
    for (int i = tid; i < 2048; i += NTHREADS) {
        const int mat = i >> 10, r = (i >> 4) & 63, kc = i & 15;
        const bf16_t* src = (mat ? WLX : WLA) + (size_t)(n * 128 + oh * 64 + r) * 128 + kc * 8;
        *(LAS u32x4*)(WL + (mat * 64 + r) * 136 + kc * 8) = *(const u32x4*)src;
    }
    float bav[2], bxv[2], lsl[2];
#pragma unroll
    for (int c2 = 0; c2 < 2; ++c2) { const int cp = n * 128 + oh * 64 + (ct0 + c2) * 16 + l15; bav[c2] = ba[cp]; bxv[c2] = bx[cp]; lsl[c2] = -log1pf(__expf(-lam[cp])); }
    const int colo = n * 128 + oh * 64 + cl;
    if (tid < 64) HC[tid] = 0.f;
    for (int c = 0; c < 64; ++c) {
        float xin[19];
        { const int t0 = c * 64 + part * 16;
#pragma unroll
          for (int i = 0; i < 19; ++i) { const int t = t0 - 3 + i; xin[i] = (t >= 0) ? bf2f(XB[(row0 + t) * HW + colc]) : 0.f; } }
        float gbv[8];
#pragma unroll
        for (int i = 0; i < 8; ++i) gbv[i] = bf2f(GB[(row0 + (size_t)c * 64 + g * 8 + i) * HW + colo]);
#pragma unroll
        for (int i = 0; i < 16; ++i) {
            const float xc = cb + w0 * xin[i + 3] + w1 * xin[i + 2] + w2 * xin[i + 1] + w3 * xin[i];
            XC[(part * 16 + i) * 136 + ch] = f2bf(xc);
            if (own) XCF[(part * 16 + i) * 65 + (ch & 63)] = xc;
        }
        __syncthreads();
        {
            f32x4 ar[2], ai[2];
            ar[0] = (f32x4){0.f, 0.f, 0.f, 0.f}; ar[1] = ar[0]; ai[0] = ar[0]; ai[1] = ar[0];
#pragma unroll
            for (int ks = 0; ks < 4; ++ks) {
                const bf16x8 af = *(const LAS bf16x8*)(XC + (st * 16 + l15) * 136 + ks * 32 + quad * 8);
#pragma unroll
                for (int c2 = 0; c2 < 2; ++c2) {
                    const bf16x8 fa = *(const LAS bf16x8*)(WL + ((ct0 + c2) * 16 + l15) * 136 + ks * 32 + quad * 8);
                    const bf16x8 fx = *(const LAS bf16x8*)(WL + (64 + (ct0 + c2) * 16 + l15) * 136 + ks * 32 + quad * 8);
                    ar[c2] = MFMA16(af, fa, ar[c2]); ai[c2] = MFMA16(af, fx, ai[c2]);
                }
            }
#pragma unroll
            for (int c2 = 0; c2 < 2; ++c2)
#pragma unroll
                for (int j = 0; j < 4; ++j) {
                    const int s = st * 16 + quad * 4 + j, cc = (ct0 + c2) * 16 + l15;
                    const float r = sigm(ar[c2][j] + bav[c2]), ig = sigm(ai[c2][j] + bxv[c2]);
                    const float la = 8.f * r * lsl[c2];
                    const float a = __expf(la);
                    float mult = sqrtf(fmaxf(-expm1f(2.f * la), 0.f));
                    if (c == 0 && s == 0) mult = 1.f;
                    AA[s * 65 + cc] = a; UU[s * 65 + cc] = XCF[s * 65 + cc] * ig * mult;
                }
        }
        __syncthreads();
        float a8[8], u8[8];
#pragma unroll
        for (int i = 0; i < 8; ++i) { a8[i] = AA[(g * 8 + i) * 65 + cl]; u8[i] = UU[(g * 8 + i) * 65 + cl]; }
        { float pa = 1.f, ph = 0.f;
#pragma unroll
          for (int i = 0; i < 8; ++i) { pa *= a8[i]; ph = a8[i] * ph + u8[i]; }
          GA[g * 64 + cl] = pa; GH[g * 64 + cl] = ph; }
        __syncthreads();
        float hh = HC[(c & 1) * 64 + cl];
        for (int g2 = 0; g2 < g; ++g2) hh = GA[g2 * 64 + cl] * hh + GH[g2 * 64 + cl];
#pragma unroll
        for (int i = 0; i < 8; ++i) { hh = a8[i] * hh + u8[i]; YAB[(row0 + (size_t)c * 64 + g * 8 + i) * D + HW + colo] = f2bf(DBG_YB_SCALE * hh * gbv[i]); }
        if (g == 7) HC[((c + 1) & 1) * 64 + cl] = hh;
    }
    __syncthreads();
}

#define XB_TMO      128
#define XB_XCNT(j)  (256  + 64 * (j))
#define XB_XSUB(j)  (1280 + 64 * (j))
#define XB_XGEN(j)  (2304 + 64 * (j))
#define XB_TOP      3328
#define XB_TOPGEN   3392
#define XCD_BAR_WORDS 3456
#define XB_SPIN_CAP (1u << 18)

__device__ __forceinline__ unsigned xb_ld(unsigned* p)              { return __hip_atomic_load(p, __ATOMIC_RELAXED, __HIP_MEMORY_SCOPE_AGENT); }
__device__ __forceinline__ unsigned xb_add(unsigned* p, unsigned v) { return __hip_atomic_fetch_add(p, v, __ATOMIC_RELAXED, __HIP_MEMORY_SCOPE_AGENT); }
__device__ __forceinline__ unsigned xb_xcc_id() { return (unsigned)__builtin_amdgcn_s_getreg((3 << 11) | 20) & 0xFu; }
#define XB_SPIN(cond, bar) do { unsigned _sp = 0; while (cond) { __builtin_amdgcn_s_sleep(1); \
    if ((++_sp & 255u) == 0u) { if (xb_ld(&(bar)[XB_TMO])) break; if (_sp > XB_SPIN_CAP) { atomicAdd(&(bar)[XB_TMO], 1u); break; } } } } while (0)

struct XcdBarrier {
    unsigned* bar; unsigned x;
    volatile LAS unsigned* st;
};

__device__ __forceinline__ XcdBarrier xcd_barrier_post(unsigned* bar, volatile LAS unsigned* st) {
    XcdBarrier b; b.bar = bar; b.x = xb_xcc_id(); b.st = st;
    if (threadIdx.x == 0) (void)xb_add(&bar[XB_XCNT(b.x)], 1u);
    return b;
}
__device__ __forceinline__ void xcd_barrier_complete(unsigned* bar, unsigned x, unsigned& nloc, unsigned& nx) {
    const unsigned G = gridDim.x * gridDim.y * gridDim.z;
    unsigned sum, cnt, mine, sp = 0u;
    for (;;) {
        sum = 0u; cnt = 0u; mine = 0u;
#pragma unroll
        for (unsigned j = 0; j < 16; ++j) { const unsigned c = xb_ld(&bar[XB_XCNT(j)]); sum += c; cnt += (c > 0u) ? 1u : 0u; mine = (j == x) ? c : mine; }
        if (sum == G) break;
        __builtin_amdgcn_s_sleep(1);
        if ((++sp & 255u) == 0u) { if (xb_ld(&bar[XB_TMO])) break; if (sp > XB_SPIN_CAP) { atomicAdd(&bar[XB_TMO], 1u); break; } }
    }
    nloc = mine > 0u ? mine : 1u; nx = cnt > 0u ? cnt : 1u;
}

__device__ __forceinline__ void xcd_barrier(const XcdBarrier& b) {
    asm volatile("s_waitcnt vmcnt(0)" ::: "memory");
    __syncthreads();
    if (threadIdx.x == 0) {
        unsigned* bar = b.bar;
        __builtin_amdgcn_s_waitcnt(0);
        unsigned nloc = b.st[0], nx = b.st[1];
        if (nloc == 0u) { xcd_barrier_complete(bar, b.x, nloc, nx); b.st[0] = nloc; b.st[1] = nx; }
        const unsigned old = xb_add(&bar[XB_XSUB(b.x)], 1u);
        const unsigned gen = old / nloc;
        if (old + 1u == (gen + 1u) * nloc) {
            __builtin_amdgcn_fence(__ATOMIC_RELEASE, "agent");
            asm volatile("s_waitcnt vmcnt(0)" ::: "memory");
            const unsigned og = xb_add(&bar[XB_TOP], 1u);
            const unsigned tg = og / nx;
            if (og + 1u == (tg + 1u) * nx) xb_add(&bar[XB_TOPGEN], 1u);
            else XB_SPIN(xb_ld(&bar[XB_TOPGEN]) == tg, bar);
            __builtin_amdgcn_fence(__ATOMIC_ACQUIRE, "agent");
            xb_add(&bar[XB_XGEN(b.x)], 1u);
            asm volatile("s_waitcnt vmcnt(0)" ::: "memory");
        } else {
            XB_SPIN(xb_ld(&bar[XB_XGEN(b.x)]) == gen, bar);
            __builtin_amdgcn_fence(__ATOMIC_ACQUIRE, "agent");
            asm volatile("s_waitcnt vmcnt(0)" ::: "memory");
        }
    }
    __syncthreads();
}

__global__ void __launch_bounds__(NTHREADS, 2) fwd_kernel(Args args) {
    extern __shared__ __attribute__((aligned(16))) unsigned char lds_raw[];
    LAS unsigned char* lds = (LAS unsigned char*)lds_raw;
    cg::grid_group grid = cg::this_grid();
    const int tid = threadIdx.x, lane = tid & 63, wave = __builtin_amdgcn_readfirstlane(tid >> 6);
    const int G = gridDim.x, bid = blockIdx.x;
    const int gw = bid * 8 + wave, NGW = G * 8;
    unsigned char* ws = args.ws;
    const float* x = args.in[0]; const float* mem = args.in[1];
    const float* ffn1_norm = args.in[2]; const float* ffn1_w_up = args.in[3]; const float* ffn1_w_down = args.in[4];
    const float* mix_norm = args.in[5]; const float* w_in = args.in[6]; const float* b_gate = args.in[7];
    const float* lb_logits = args.in[8]; const float* hgrn_norm = args.in[9];
    const float* conv_w = args.in[10]; const float* conv_b = args.in[11];
    const float* lru_wa = args.in[12]; const float* lru_ba = args.in[13]; const float* lru_wx = args.in[14]; const float* lru_bx = args.in[15]; const float* lru_lambda = args.in[16];
    const float* w_branch_a = args.in[17]; const float* w_branch_b = args.in[18]; const float* w_out = args.in[19];
    const float* xattn_norm = args.in[20]; const float* mem_norm = args.in[21]; const float* xattn_wq = args.in[22]; const float* xattn_wkv = args.in[23]; const float* xattn_wo = args.in[24];
    const float* ffn2_norm = args.in[25]; const float* ffn2_w_up = args.in[26]; const float* ffn2_w_down = args.in[27]; const float* final_norm = args.in[28];
    float* out = args.out;
    bf16_t* Wb = (bf16_t*)(ws + WS_W);
    bf16_t *WUP1 = Wb + E_WUP1, *WDN1 = Wb + E_WDN1, *WIN = Wb + E_WIN, *WAB = Wb + E_WAB, *WOUT = Wb + E_WOUT, *WQ = Wb + E_WQ, *WKV = Wb + E_WKV, *WO = Wb + E_WO,
           *WUP2 = Wb + E_WUP2, *WDN2 = Wb + E_WDN2, *WLA = Wb + E_WLA, *WLX = Wb + E_WLX;
    float* LB = (float*)(ws + WS_CTL);
    bf16_t* XN = (bf16_t*)(ws + WS_XN); bf16_t* YAB = (bf16_t*)(ws + WS_YAB); bf16_t* HB = (bf16_t*)(ws + WS_HB);
    bf16_t *QS = (bf16_t*)(ws + WS_QS), *KK = (bf16_t*)(ws + WS_KK), *VV = (bf16_t*)(ws + WS_VV), *GS = (bf16_t*)(ws + WS_GS), *XB = (bf16_t*)(ws + WS_XB), *GB = (bf16_t*)(ws + WS_GB);
    float* LF = (float*)(ws + WS_LF);
    bf16_t *GAB = (bf16_t*)(ws + WS_GAB), *MG = (bf16_t*)(ws + WS_MG), *Qb = (bf16_t*)(ws + WS_Q), *Pb = (bf16_t*)(ws + WS_P), *Ob = (bf16_t*)(ws + WS_O);
    bf16_t *KMAT = (bf16_t*)(ws + WS_KMAT), *VT = (bf16_t*)(ws + WS_VT), *MEMN = (bf16_t*)(ws + WS_MEMN);

    const int lo = args.ph_lo, hi = args.ph_hi;
#ifndef DUP_MASK
#define DUP_MASK 0
#endif
#ifndef PH_MASK
#define PH_MASK 0x3ffff
#endif
#define IN(k) (((PH_MASK >> (k)) & 1) && lo <= (k) && (k) < hi)
#define SEAM(k) do { if (lo <= (k) && (k) + 1 < hi) { if ((k) == 0) { asm volatile("s_waitcnt vmcnt(0) lgkmcnt(0)" ::: "memory"); __syncthreads(); grid.sync(); \
        if (tid == 0) { __builtin_amdgcn_fence(__ATOMIC_ACQUIRE, "agent"); asm volatile("s_waitcnt vmcnt(0)" ::: "memory"); } __syncthreads(); } else { xcd_barrier(xbar); } } } while (0)
    volatile LAS unsigned* MISC = (volatile LAS unsigned*)(lds + STAGE_BYTES + 12288);
    if (tid < 4) MISC[tid] = 0u;
    __syncthreads();
    XcdBarrier xbar = xcd_barrier_post((unsigned*)(ws + WS_CTL + 131072), MISC);

    if (IN(0)) {
        LAS float* scr = (LAS float*)(lds + wave * 16384);
        transpose_matrix(ffn1_w_up, D, 2 * DFF, WUP1, D, 0, 1, scr, gw, NGW, lane);
        transpose_matrix(ffn1_w_down, DFF, D, WDN1, DFF, 0, 0, scr, gw, NGW, lane);
        transpose_matrix(w_in, D, 10240, WIN, D, 0, 0, scr, gw, NGW, lane);
        transpose_matrix(w_branch_a, HW, D, WAB, D, 0, 0, scr, gw, NGW, lane);
        transpose_matrix(w_branch_b, HW, D, WAB, D, HW, 0, scr, gw, NGW, lane);
        transpose_matrix(w_out, D, D, WOUT, D, 0, 0, scr, gw, NGW, lane);
        transpose_matrix(xattn_wq, D, D, WQ, D, 0, 0, scr, gw, NGW, lane);
        transpose_matrix(xattn_wkv, D, 2 * D, WKV, D, 0, 0, scr, gw, NGW, lane);
        transpose_matrix(xattn_wo, D, D, WO, D, 0, 0, scr, gw, NGW, lane);
        transpose_matrix(ffn2_w_up, D, 2 * DFF, WUP2, D, 0, 1, scr, gw, NGW, lane);
        transpose_matrix(ffn2_w_down, DFF, D, WDN2, DFF, 0, 0, scr, gw, NGW, lane);
        for (int nb = 0; nb < 8; ++nb) {
            transpose_matrix(lru_wa + nb * 16384, 128, 128, WLA + nb * 16384, 128, 0, 0, scr, gw, NGW, lane);
            transpose_matrix(lru_wx + nb * 16384, 128, 128, WLX + nb * 16384, 128, 0, 0, scr, gw, NGW, lane);
        }
        norm_all_bf16(x, ffn1_norm, XN, gw, NGW, lane);
        for (int m = gw; m < NBATCH * NMEM; m += NGW) rms_row_bf16(mem + (size_t)m * D, mem_norm, MEMN + (size_t)m * D, lane);
        for (int i = bid * NTHREADS + tid; i < HW; i += G * NTHREADS) LB[i] = sigm(lb_logits[i] - lb_logits[HW + i]);
        __syncthreads();
    }
    SEAM(0);
    if (IN(1)) { pg8::StdOrder S; S.init(T, 2 * DFF, G, bid, D, D, DFF, 128); pg8::EpiSwiGLU E{HB}; pg8::gemm_phase(lds, XN, WUP1, D, D, D, S, E); }
    SEAM(1);
    if (IN(2)) { pg8::StdOrder S; S.init(T, D, G, bid, DFF, DFF, D, 256); pg8::EpiResid E{x, out, 0.5f}; pg8::gemm_phase(lds, HB, WDN1, DFF, DFF, DFF, S, E); }
    SEAM(2);
    if (IN(3)) {
        { pg8::StdOrder S; S.init(NBATCH * NMEM, D, G, bid, D, D, D, 256); pg8::EpiBf16 E{KMAT, D, 1.f}; pg8::gemm_phase(lds, MEMN, WKV, D, D, D, S, E); }
        { pg8::StdOrder S; S.init(D, NBATCH * NMEM, G, (bid + 64) % G, D, D, D, 256); pg8::EpiBf16 E{VT, D, 1.f}; pg8::gemm_phase(lds, WKV + (size_t)D * D, MEMN, D, D, D, S, E); }
        norm_all_bf16(out, mix_norm, XN, gw, NGW, lane);
    }
    SEAM(3);
    if (IN(4)) { pg8::StdOrder S; S.init(T, 6144, G, bid, D, D, HW, 256); pg8::EpiWin E{QS, KK, VV, GS, XB, GB, LF, LB}; pg8::gemm_phase(lds, XN, WIN, D, D, D, S, E); }
    SEAM(4);
    for (int rep_ = 0; rep_ < (((DUP_MASK >> 5) & 1) ? 2 : 1); ++rep_)
    if (IN(5)) {
        for (int it = bid; it < 256; it += G) {
            if (it < 128) hgrn_item(lds, it, QS, LF, KK, VV, YAB);
            else lru_item(lds, it - 128, XB, GB, conv_w, conv_b, WLA, WLX, lru_ba, lru_bx, lru_lambda, YAB);
        }
    }
    SEAM(5);
    if (IN(6)) {
        for (int m = gw; m < T; m += NGW) {
            bf16_t* orow = YAB + (size_t)m * D + lane * 16;
            const u32x4 a = *(const u32x4*)orow, b2 = *(const u32x4*)(orow + 8);
            float v[16] = {bflo(a.x), bfhi(a.x), bflo(a.y), bfhi(a.y), bflo(a.z), bfhi(a.z), bflo(a.w), bfhi(a.w), bflo(b2.x), bfhi(b2.x), bflo(b2.y), bfhi(b2.y), bflo(b2.z), bfhi(b2.z), bflo(b2.w), bfhi(b2.w)};
            float s = 0.f;
#pragma unroll
            for (int i = 0; i < 16; ++i) s += v[i] * v[i];
            s += __shfl_xor(s, 1); s += __shfl_xor(s, 2); s += __shfl_xor(s, 4);
            const float rstd = rsqrtf(s * (1.f / 128.f) + EPS);
            const bf16_t* grow = GS + (size_t)m * HW + lane * 16;
            const u32x4 ga = *(const u32x4*)grow, gb2 = *(const u32x4*)(grow + 8);
            const float gsv[16] = {bflo(ga.x), bfhi(ga.x), bflo(ga.y), bfhi(ga.y), bflo(ga.z), bfhi(ga.z), bflo(ga.w), bfhi(ga.w), bflo(gb2.x), bfhi(gb2.x), bflo(gb2.y), bfhi(gb2.y), bflo(gb2.z), bfhi(gb2.z), bflo(gb2.w), bfhi(gb2.w)};
            const float* hn = hgrn_norm + lane * 16;
#pragma unroll
            for (int i = 0; i < 16; ++i) v[i] = v[i] * rstd * hn[i] * gsv[i];
            u32x4 o0, o1;
            o0.x = cvt_pk_bf16(v[0], v[1]); o0.y = cvt_pk_bf16(v[2], v[3]); o0.z = cvt_pk_bf16(v[4], v[5]); o0.w = cvt_pk_bf16(v[6], v[7]);
            o1.x = cvt_pk_bf16(v[8], v[9]); o1.y = cvt_pk_bf16(v[10], v[11]); o1.z = cvt_pk_bf16(v[12], v[13]); o1.w = cvt_pk_bf16(v[14], v[15]);
            *(u32x4*)orow = o0; *(u32x4*)(orow + 8) = o1;
        }
        __syncthreads();
        { pg8::StdOrder S; S.init(T, 4096, G, bid, D, D, 4096, 256); pg8::EpiGates E{GAB, b_gate}; pg8::gemm_phase(lds, XN, WIN + (size_t)6144 * D, D, D, D, S, E); }
    }
    SEAM(6);
    if (IN(7)) {
        pg8::StdOrder S; S.init(T, D, G, bid, D, D, D, 256);
        { pg8::EpiMerge<0> E{GAB, MG}; pg8::gemm_phase(lds, YAB, WAB, HW, D, D, S, E); }
        { pg8::EpiMerge<1> E{GAB, MG}; pg8::gemm_phase(lds, YAB + HW, WAB + HW, HW, D, D, S, E); }
    }
    SEAM(7);
    if (IN(8)) { pg8::StdOrder S; S.init(T, D, G, bid, D, D, D, 256); pg8::EpiResid E{out, out, 1.f}; pg8::gemm_phase(lds, MG, WOUT, D, D, D, S, E); }
    SEAM(8);
    if (IN(9)) { norm_all_bf16(out, xattn_norm, XN, gw, NGW, lane); }
    SEAM(9);
    if (IN(10)) { pg8::StdOrder S; S.init(T, D, G, bid, D, D, D, 256); pg8::EpiBf16 E{Qb, D, 0.044194173824159216f}; pg8::gemm_phase(lds, XN, WQ, D, D, D, S, E); }
    SEAM(10);
    if (IN(11)) { pg8::ScoreOrder S{G, bid}; pg8::EpiSoftmax E{Pb, (LAS float*)(lds + STAGE_BYTES), (LAS float*)(lds + STAGE_BYTES + 4096)}; pg8::gemm_phase<pg8::EpiSoftmax, pg8::ScoreOrder, false, false>(lds, Qb, KMAT, XD, D, D, S, E); }
    SEAM(11);
    if (IN(12)) { pg8::PvOrder S{G, bid}; pg8::EpiBf16 E{Ob, D, 1.f}; pg8::gemm_phase<pg8::EpiBf16, pg8::PvOrder, false, false>(lds, Pb, VT, NMEM, NMEM, D, S, E); }
    SEAM(12);
    if (IN(13)) { pg8::StdOrder S; S.init(T, D, G, bid, D, D, D, 256); pg8::EpiResid E{out, out, 1.f}; pg8::gemm_phase(lds, Ob, WO, D, D, D, S, E); }
    SEAM(13);
    if (IN(14)) { norm_all_bf16(out, ffn2_norm, XN, gw, NGW, lane); }
    SEAM(14);
    if (IN(15)) { pg8::StdOrder S; S.init(T, 2 * DFF, G, bid, D, D, DFF, 128); pg8::EpiSwiGLU E{HB}; pg8::gemm_phase(lds, XN, WUP2, D, D, D, S, E); }
    SEAM(15);
    if (IN(16)) { pg8::StdOrder S; S.init(T, D, G, bid, DFF, DFF, D, 256); pg8::EpiResid E{out, out, 0.5f}; pg8::gemm_phase(lds, HB, WDN2, DFF, DFF, DFF, S, E); }
    SEAM(16);
    if (IN(17)) { for (int m = gw; m < T; m += NGW) rms_row_f32(out + (size_t)m * D, final_norm, lane); }
#undef IN
#undef SEAM
}

constexpr int N_PHASES = 18;

extern "C" void kernel_launch(void* const* d_in, const int* in_sizes, int n_in, void* d_out, int out_size, void* d_ws, size_t ws_size, hipStream_t stream) {
    static int grid = 0;
    if (grid == 0) {
        if (n_in != 29 || out_size != T * D || ws_size < WS_END) { fprintf(stderr, "kernel_launch: unexpected shapes (n_in %d, out %d, ws %zu)\n", n_in, out_size, ws_size); grid = -1; return; }
        int dev = 0, cus = 0, per_cu = 0;
        (void)hipGetDevice(&dev);
        (void)hipDeviceGetAttribute(&cus, hipDeviceAttributeMultiprocessorCount, dev);
        if (hipFuncSetAttribute((const void*)fwd_kernel, hipFuncAttributeMaxDynamicSharedMemorySize, LDS_BYTES) != hipSuccess) { fprintf(stderr, "kernel_launch: hipFuncSetAttribute failed\n"); grid = -1; return; }
        if (hipOccupancyMaxActiveBlocksPerMultiprocessor(&per_cu, (const void*)fwd_kernel, NTHREADS, LDS_BYTES) != hipSuccess || per_cu < 1) { fprintf(stderr, "kernel_launch: occupancy query gave %d\n", per_cu); per_cu = 1; }
        (void)hipGetLastError();
        grid = cus * 1;
        if (grid <= 0) grid = 256;
    }
    if (grid < 0) return;
    (void)hipMemsetAsync((char*)d_ws + WS_CTL + 131072, 0, 16384, stream);
    Args a{};
    for (int i = 0; i < 29; ++i) a.in[i] = (const float*)d_in[i];
    a.out = (float*)d_out; a.ws = (unsigned char*)d_ws; a.ph_lo = 0; a.ph_hi = N_PHASES;
    void* kargs[] = {&a};
    hipError_t e = hipLaunchCooperativeKernel((const void*)fwd_kernel, dim3(grid), dim3(NTHREADS), kargs, LDS_BYTES, stream);
    if (e != hipSuccess) fprintf(stderr, "kernel_launch: cooperative launch failed: %s (grid %d)\n", hipGetErrorString(e), grid);
}
```

```cpp
#ifndef DBG_YB_SCALE
#define DBG_YB_SCALE 1.f
#endif
#include <hip/hip_runtime.h>
#include <hip/hip_cooperative_groups.h>
#include <cstdio>
#include <cstdint>
namespace cg = cooperative_groups;

#define LAS __attribute__((address_space(3)))
typedef unsigned short bf16_t;
typedef short bf16x8 __attribute__((ext_vector_type(8)));
typedef float f32x4 __attribute__((ext_vector_type(4)));
typedef unsigned u32x4 __attribute__((ext_vector_type(4)));
typedef unsigned u32x2 __attribute__((ext_vector_type(2)));

constexpr int T = 32768, D = 2048, DFF = 5632, NBATCH = 8, SEQ = 4096, HW = 1024, NMEM = 256, XH = 4, XD = 512;
constexpr float EPS = 1e-6f;
constexpr int NTHREADS = 512;
constexpr int STAGE_BYTES = 131072, LDS_BYTES = STAGE_BYTES + 16384;

constexpr size_t MiB = 1ull << 20;
constexpr size_t WS_CTL = 0;
constexpr size_t WS_W = 1 * MiB;
constexpr size_t E_WUP1 = 0, E_WDN1 = E_WUP1 + 23068672ull, E_WIN = E_WDN1 + 11534336ull, E_WAB = E_WIN + 20971520ull, E_WOUT = E_WAB + 4194304ull,
                 E_WQ = E_WOUT + 4194304ull, E_WKV = E_WQ + 4194304ull, E_WO = E_WKV + 8388608ull, E_WUP2 = E_WO + 4194304ull, E_WDN2 = E_WUP2 + 23068672ull,
                 E_WLA = E_WDN2 + 11534336ull, E_WLX = E_WLA + 131072ull, E_WEND = E_WLX + 131072ull;
static_assert(E_WEND * 2 <= 221 * MiB, "weights region");
constexpr size_t WS_XN = 222 * MiB;
constexpr size_t WS_YAB = 350 * MiB;
constexpr size_t WS_BIG = 478 * MiB;
constexpr size_t WS_HB = WS_BIG;
constexpr size_t WS_QS = WS_BIG, WS_KK = WS_BIG + 64 * MiB, WS_VV = WS_BIG + 128 * MiB, WS_GS = WS_BIG + 192 * MiB, WS_XB = WS_BIG + 256 * MiB,
                 WS_GB = WS_BIG + 320 * MiB, WS_LF = WS_BIG + 384 * MiB;
constexpr size_t WS_GAB = WS_BIG + 256 * MiB;
constexpr size_t WS_MG = WS_BIG;
constexpr size_t WS_Q = WS_BIG + 128 * MiB;
constexpr size_t WS_P = WS_BIG + 256 * MiB;
constexpr size_t WS_O = WS_BIG + 320 * MiB;
constexpr size_t WS_KMAT = WS_BIG + 512 * MiB;
constexpr size_t WS_VT = WS_BIG + 520 * MiB;
constexpr size_t WS_MEMN = WS_BIG + 528 * MiB;
constexpr size_t WS_END = WS_BIG + 536 * MiB;
static_assert(WS_END <= 1024 * MiB, "workspace");

typedef float f32x2_c __attribute__((ext_vector_type(2)));
typedef __bf16 bf16x2_c __attribute__((ext_vector_type(2)));
__device__ __forceinline__ unsigned cvt_pk_bf16(float lo, float hi) { f32x2_c v = {lo, hi}; bf16x2_c r = __builtin_convertvector(v, bf16x2_c); return __builtin_bit_cast(unsigned, r); }
__device__ __forceinline__ bf16_t f2bf(float f) { return (bf16_t)(cvt_pk_bf16(f, 0.f) & 0xffffu); }
__device__ __forceinline__ float bf2f(bf16_t b) { return __uint_as_float(((unsigned)b) << 16); }
__device__ __forceinline__ float bflo(unsigned w) { return __uint_as_float(w << 16); }
__device__ __forceinline__ float bfhi(unsigned w) { return __uint_as_float(w & 0xffff0000u); }
__device__ __forceinline__ float sigm(float x) { return __builtin_amdgcn_rcpf(1.f + __expf(-x)); }
__device__ __forceinline__ float siluf(float x) { return x * sigm(x); }
__device__ __forceinline__ float gelu_tanh(float x) { return x * sigm(1.5957691216f * (x + 0.044715f * x * x * x)); }
__device__ __forceinline__ float wave_sum(float v) {
#pragma unroll
    for (int o = 1; o < 64; o <<= 1) v += __shfl_xor(v, o);
    return v;
}
#define LDS_WAIT() asm volatile("s_waitcnt lgkmcnt(0)" ::: "memory")

namespace pg8 {
constexpr int BM = 256, BK = 64, HALF = 128, HTB = HALF * BK * 2, NXCD = 8, WGM = 8;
__host__ __device__ __forceinline__ int lds_byte(int r, int c) { const int st = (r >> 4) * 2 + (c >> 5), rr = r & 15, cc = c & 31, ob = rr * 64 + cc * 2; return st * 1024 + (ob ^ (((ob >> 9) & 1) << 5)); }
__host__ __device__ __forceinline__ void stage_rc(int b, int& R, int& C) { const int st = b / 1024, sb = b % 1024, swz = sb ^ (((sb >> 9) & 1) << 5); R = (st >> 1) * 16 + swz / 64; C = (st & 1) * 32 + (swz % 64) / 2; }
__host__ __device__ __forceinline__ int perm32(int rho) { const int n = rho >> 4, i = rho & 15; return 8 * (i >> 2) + 4 * n + (i & 3); }

struct Unit { int pm, pn; size_t aoff, boff, ooff; };

struct StdOrder {
    int nM, nN, nwg, G, c; size_t ta, tb, ldc; int ocols;
    __device__ void init(int M, int N, int G_, int c_, int lda, int ldb, int ldc_, int ocols_) { nM = M / BM; nN = N / BM; nwg = nM * nN; G = G_; c = c_; ta = (size_t)BM * lda * 2; tb = (size_t)BM * ldb * 2; ldc = (size_t)ldc_; ocols = ocols_; }
    __device__ bool next(int i, Unit& u) const {
        const long L = (long)i * G + c; if (L >= nwg) return false;
        int wgid = (int)L; { const int q = nwg / NXCD, r = nwg % NXCD, xcd = wgid % NXCD, off = wgid / NXCD; wgid = (xcd < r ? xcd * (q + 1) : r * (q + 1) + (xcd - r) * q) + off; }
        const int nig = WGM * nN, gid = wgid / nig, fm = gid * WGM, gsz = (nM - fm) < WGM ? (nM - fm) : WGM;
        u.pm = fm + ((wgid % nig) % gsz); u.pn = (wgid % nig) / gsz;
        u.aoff = (size_t)u.pm * ta; u.boff = (size_t)u.pn * tb; u.ooff = (size_t)u.pm * BM * ldc + (size_t)u.pn * ocols; return true;
    }
};
struct MtOrder {
    int G, c;
    __device__ bool next(int i, Unit& u) const {
        const int L = i * G + c; if (L >= 256) return false;
        const int nt = L & 7, bh = L >> 3, b = bh >> 2, h = bh & 3;
        u.pm = bh; u.pn = nt;
        u.aoff = ((size_t)(b * NMEM) * D + (size_t)h * XD) * 2; u.boff = ((size_t)(nt * 256) * D + (size_t)h * XD) * 2; u.ooff = (size_t)bh * 256 * D + (size_t)nt * 256; return true;
    }
};
struct NtOrder {
    int G, c;
    __device__ bool next(int i, Unit& u) const {
        const int L = i * G + c; if (L >= 256) return false;
        const int mt = L & 7, bh = L >> 3, b = bh >> 2, h = bh & 3;
        u.pm = mt; u.pn = bh;
        u.aoff = ((size_t)(mt * 256) * D + (size_t)h * XD) * 2; u.boff = ((size_t)(b * NMEM) * D + (size_t)h * XD) * 2; u.ooff = (size_t)b * D * 1024 + (size_t)(mt * 256) * 1024 + (size_t)h * 256; return true;
    }
};
struct ScoreOrder {
    int G, c;
    __device__ bool next(int i, Unit& u) const {
        const int L = i * G + c; if (L >= NBATCH * XH * 16) return false;
        const int qt = L & 15, h = (L >> 4) & 3, b = L >> 6;
        u.pm = L; u.pn = 0;
        u.aoff = (size_t)(b * SEQ + qt * 256) * D * 2; u.boff = (size_t)(b * XH + h) * 256 * D * 2; u.ooff = (size_t)(b * SEQ + qt * 256) * 1024 + (size_t)h * 256; return true;
    }
};
struct OutOrder : StdOrder {
    __device__ bool next(int i, Unit& u) const {
        if (!StdOrder::next(i, u)) return false;
        u.boff += (size_t)(u.pm >> 4) * D * 1024 * 2; return true;
    }
};

template <class Epi, class Sched, bool ALIGN_EPI = true, bool SP2 = true>
__device__ __forceinline__ void gemm_phase(LAS unsigned char* lds, const bf16_t* Ag, const bf16_t* Btg, const int K, const int lda, const int ldb, const Sched& S, const Epi& E) {
    const int tid = threadIdx.x, wid = __builtin_amdgcn_readfirstlane(tid >> 6), lane = tid & 63, wr = wid >> 2, wc = wid & 3, fr = lane & 15, fq = lane >> 4;
    const int nt = K / BK;
    unsigned voffA[2], voffB[2];
#pragma unroll
    for (int i = 0; i < 2; ++i) { int R, C; stage_rc(tid * 16 + i * 8192, R, C); const int Rb = Epi::PERM ? ((R & ~31) + perm32(R & 31)) : R;
        voffA[i] = (unsigned)(R * lda + C) * 2u; voffB[i] = (unsigned)(Rb * ldb + C) * 2u; }
    const size_t kstep = (size_t)(BK * 2);
    const size_t hstepA = (size_t)HALF * lda * 2, hstepB = (size_t)HALF * ldb * 2;
    const unsigned ldsw = (unsigned)wid * 1024u;
    const int aoff = lds_byte(wr * 64 + fr, fq * 8), boff = lds_byte(wc * 32 + fr, fq * 8);
#define PG8_SA(b, h) (((b) * 2 + (h)) * HTB)
#define PG8_SB(b, h) ((4 + (b) * 2 + (h)) * HTB)
#define PG8_STAGE(bufoff, gbase, voff) do { _Pragma("unroll") for (int _i = 0; _i < 2; ++_i) \
        __builtin_amdgcn_global_load_lds((const unsigned*)((const char*)(gbase) + (voff)[_i]), (LAS unsigned*)(lds + (bufoff) + ldsw + _i * 8192), 16, 0, 0); } while (0)
#define PG8_LDA(dst, b, h) do { _Pragma("unroll") for (int m = 0; m < 4; ++m) _Pragma("unroll") for (int k = 0; k < 2; ++k) dst[m][k] = *(const LAS bf16x8*)(lds + PG8_SA(b, h) + aoff + m * 2048 + k * 1024); } while (0)
#define PG8_LDB(dst, b, h) do { _Pragma("unroll") for (int n = 0; n < 2; ++n) _Pragma("unroll") for (int k = 0; k < 2; ++k) dst[n][k] = *(const LAS bf16x8*)(lds + PG8_SB(b, h) + boff + n * 2048 + k * 1024); } while (0)
#define PG8_MMA(ai, bj, At, Bt) do { __builtin_amdgcn_s_setprio(1); _Pragma("unroll") for (int m = 0; m < 4; ++m) _Pragma("unroll") for (int n = 0; n < 2; ++n) _Pragma("unroll") for (int k = 0; k < 2; ++k) \
        acc[ai][bj][m][n] = __builtin_amdgcn_mfma_f32_16x16x32_bf16(Bt[n][k], At[m][k], acc[ai][bj][m][n], 0, 0, 0); __builtin_amdgcn_s_setprio(0); } while (0)
#define PG8_WAIT_V(n) asm volatile("s_waitcnt vmcnt(" #n ")" ::: "memory")
#define PG8_WAIT_L(n) asm volatile("s_waitcnt lgkmcnt(" #n ")" ::: "memory")
#define PG8_BAR __builtin_amdgcn_s_barrier()
#define PG8_SCHED __builtin_amdgcn_sched_barrier(0)
    Unit cur, nxt; int ui = 0;
    if (!S.next(0, cur)) return;
    f32x4 acc[2][2][4][2];
#pragma unroll
    for (int a = 0; a < 2; ++a)
#pragma unroll
        for (int b = 0; b < 2; ++b)
#pragma unroll
            for (int m = 0; m < 4; ++m)
#pragma unroll
                for (int n = 0; n < 2; ++n) acc[a][b][m][n] = (f32x4){0.f, 0.f, 0.f, 0.f};
    bf16x8 At[4][2], B0[2][2], B1[2][2];
    const char* cA = (const char*)Ag + cur.aoff; const char* cB = (const char*)Btg + cur.boff;
    if constexpr (SP2) {
        PG8_STAGE(PG8_SB(0, 0), cB, voffB); PG8_STAGE(PG8_SB(0, 1), cB + hstepB, voffB); PG8_STAGE(PG8_SA(0, 0), cA, voffA); PG8_STAGE(PG8_SA(0, 1), cA + hstepA, voffA);
        if (wr == 1) PG8_BAR;
        PG8_WAIT_V(2); PG8_BAR;
        PG8_STAGE(PG8_SB(1, 0), cB + kstep, voffB); PG8_STAGE(PG8_SA(1, 0), cA + kstep, voffA); PG8_STAGE(PG8_SB(1, 1), cB + hstepB + kstep, voffB);
        PG8_WAIT_V(6); PG8_BAR;
    } else {
    PG8_STAGE(PG8_SB(0, 0), cB, voffB); PG8_STAGE(PG8_SA(0, 0), cA, voffA); PG8_STAGE(PG8_SB(0, 1), cB + hstepB, voffB); PG8_STAGE(PG8_SA(0, 1), cA + hstepA, voffA);
    if (wr == 1) PG8_BAR;
    PG8_WAIT_V(4); PG8_BAR;
    PG8_STAGE(PG8_SB(1, 0), cB + kstep, voffB); PG8_STAGE(PG8_SA(1, 0), cA + kstep, voffA); PG8_STAGE(PG8_SB(1, 1), cB + hstepB + kstep, voffB);
    PG8_WAIT_V(6); PG8_BAR;
    }
    for (;;) {
        const bool has_next = S.next(ui + 1, nxt);
        const char* nA = has_next ? (const char*)Ag + nxt.aoff : cA; const char* nB = has_next ? (const char*)Btg + nxt.boff : cB;
        for (int t = 0; t < nt; t += 2) {
            const bool last = (t == nt - 2);
            const char* a1 = cA + (size_t)(t + 1) * kstep;
            const char* a2 = last ? nA : cA + (size_t)(t + 2) * kstep; const char* b2 = last ? nB : cB + (size_t)(t + 2) * kstep;
            const char* a3 = a2 + kstep; const char* b3 = b2 + kstep;
            if constexpr (SP2) {
            PG8_LDB(B0, 0, 0); PG8_LDB(B1, 0, 1); PG8_SCHED; PG8_LDA(At, 0, 0); PG8_STAGE(PG8_SA(1, 1), a1 + hstepA, voffA);
            PG8_WAIT_V(8); PG8_WAIT_L(0); PG8_BAR; PG8_MMA(0, 0, At, B0); PG8_MMA(0, 1, At, B1); PG8_BAR; PG8_SCHED;
            PG8_LDA(At, 0, 1); PG8_STAGE(PG8_SB(0, 0), b2, voffB); PG8_STAGE(PG8_SB(0, 1), b2 + hstepB, voffB); PG8_STAGE(PG8_SA(0, 0), a2, voffA);
            PG8_WAIT_V(8); PG8_WAIT_L(0); PG8_BAR; PG8_MMA(1, 0, At, B0); PG8_MMA(1, 1, At, B1); PG8_BAR; PG8_SCHED;
            PG8_LDB(B0, 1, 0); PG8_LDB(B1, 1, 1); PG8_SCHED; PG8_LDA(At, 1, 0); PG8_STAGE(PG8_SA(0, 1), a2 + hstepA, voffA);
            PG8_WAIT_V(8); PG8_WAIT_L(0); PG8_BAR; PG8_MMA(0, 0, At, B0); PG8_MMA(0, 1, At, B1); PG8_BAR; PG8_SCHED;
            PG8_LDA(At, 1, 1); PG8_STAGE(PG8_SB(1, 0), b3, voffB); PG8_STAGE(PG8_SB(1, 1), b3 + hstepB, voffB); PG8_STAGE(PG8_SA(1, 0), a3, voffA);
            PG8_WAIT_V(8); PG8_WAIT_L(0); PG8_BAR; PG8_MMA(1, 0, At, B0); PG8_MMA(1, 1, At, B1); PG8_BAR; PG8_SCHED;
            } else {
            PG8_LDB(B0, 0, 0); PG8_SCHED; PG8_LDA(At, 0, 0); PG8_STAGE(PG8_SA(1, 1), a1 + hstepA, voffA);
            PG8_WAIT_L(8); PG8_BAR; PG8_WAIT_L(0); PG8_MMA(0, 0, At, B0); PG8_BAR; PG8_SCHED;
            PG8_LDB(B1, 0, 1); PG8_STAGE(PG8_SB(0, 0), b2, voffB);
            PG8_BAR; PG8_WAIT_L(0); PG8_MMA(0, 1, At, B1); PG8_BAR;
            PG8_LDA(At, 0, 1); PG8_STAGE(PG8_SA(0, 0), a2, voffA);
            PG8_BAR; PG8_WAIT_L(0); PG8_MMA(1, 0, At, B0); PG8_BAR; PG8_SCHED;
            PG8_STAGE(PG8_SB(0, 1), b2 + hstepB, voffB);
            PG8_WAIT_V(6); PG8_BAR; PG8_MMA(1, 1, At, B1); PG8_BAR;
            PG8_LDB(B0, 1, 0); PG8_SCHED; PG8_LDA(At, 1, 0); PG8_STAGE(PG8_SA(0, 1), a2 + hstepA, voffA);
            PG8_WAIT_L(8); PG8_BAR; PG8_WAIT_L(0); PG8_MMA(0, 0, At, B0); PG8_BAR; PG8_SCHED;
            PG8_LDB(B1, 1, 1); PG8_STAGE(PG8_SB(1, 0), b3, voffB);
            PG8_BAR; PG8_WAIT_L(0); PG8_MMA(0, 1, At, B1); PG8_BAR;
            PG8_LDA(At, 1, 1); PG8_STAGE(PG8_SA(1, 0), a3, voffA);
            PG8_BAR; PG8_WAIT_L(0); PG8_MMA(1, 0, At, B0); PG8_BAR; PG8_SCHED;
            PG8_STAGE(PG8_SB(1, 1), b3 + hstepB, voffB);
            PG8_WAIT_V(6); PG8_BAR; PG8_MMA(1, 1, At, B1); PG8_BAR;
            }
        }
        if constexpr (ALIGN_EPI) { if (wr == 0) PG8_BAR; }
        E(acc, cur, wr, wc, fr, fq);
        if (!has_next) break;
#pragma unroll
        for (int a = 0; a < 2; ++a)
#pragma unroll
            for (int b = 0; b < 2; ++b)
#pragma unroll
                for (int m = 0; m < 4; ++m)
#pragma unroll
                    for (int n = 0; n < 2; ++n) acc[a][b][m][n] = (f32x4){0.f, 0.f, 0.f, 0.f};
        cur = nxt; cA = nA; cB = nB; ++ui;
        if constexpr (ALIGN_EPI) { if (wr == 1) PG8_BAR; }
    }
    PG8_WAIT_V(0);
    if constexpr (!ALIGN_EPI) { if (wr == 0) PG8_BAR; }
    PG8_BAR;
#undef PG8_SA
#undef PG8_SB
#undef PG8_STAGE
#undef PG8_LDA
#undef PG8_LDB
#undef PG8_MMA
#undef PG8_WAIT_V
#undef PG8_WAIT_L
#undef PG8_BAR
#undef PG8_SCHED
}

typedef f32x4 Acc[2][2][4][2];
__device__ __forceinline__ u32x4 pack8(const f32x4 a, const f32x4 b) { u32x4 w; w.x = cvt_pk_bf16(a[0], a[1]); w.y = cvt_pk_bf16(a[2], a[3]); w.z = cvt_pk_bf16(b[0], b[1]); w.w = cvt_pk_bf16(b[2], b[3]); return w; }

struct EpiSwiGLU {
    static constexpr bool PERM = true, MIDK = false;
    bf16_t* H;
    __device__ __forceinline__ void operator()(Acc& acc, const Unit& u, int wr, int wc, int fr, int fq) const {
        bf16_t* base = H + u.ooff + (size_t)(wr * 64 + fr) * DFF + wc * 32 + 8 * fq;
#pragma unroll
        for (int ai = 0; ai < 2; ++ai)
#pragma unroll
            for (int m = 0; m < 4; ++m) {
                f32x4 h0, h1;
#pragma unroll
                for (int j = 0; j < 4; ++j) { h0[j] = siluf(acc[ai][0][m][0][j]) * acc[ai][1][m][0][j]; h1[j] = siluf(acc[ai][0][m][1][j]) * acc[ai][1][m][1][j]; }
                *(u32x4*)(base + (size_t)(ai * 128 + m * 16) * DFF) = pack8(h0, h1);
            }
    }
};
struct EpiResid {
    static constexpr bool PERM = true, MIDK = false;
    const float* R; float* O; float scale;
    __device__ __forceinline__ void operator()(Acc& acc, const Unit& u, int wr, int wc, int fr, int fq) const {
        const size_t p0 = u.ooff + (size_t)(wr * 64 + fr) * D + wc * 32 + 8 * fq;
#pragma unroll
        for (int ai = 0; ai < 2; ++ai)
#pragma unroll
            for (int m = 0; m < 4; ++m)
#pragma unroll
                for (int bj = 0; bj < 2; ++bj) {
                    const size_t p = p0 + (size_t)(ai * 128 + m * 16) * D + bj * 128;
                    const f32x4 r0 = *(const f32x4*)(R + p), r1 = *(const f32x4*)(R + p + 4);
                    *(f32x4*)(O + p) = r0 + acc[ai][bj][m][0] * scale; *(f32x4*)(O + p + 4) = r1 + acc[ai][bj][m][1] * scale;
                }
    }
};
struct EpiBf16 {
    static constexpr bool PERM = true, MIDK = false;
    bf16_t* O; int ldc; float scale;
    __device__ __forceinline__ void operator()(Acc& acc, const Unit& u, int wr, int wc, int fr, int fq) const {
        bf16_t* base = O + u.ooff + (size_t)(wr * 64 + fr) * ldc + wc * 32 + 8 * fq;
#pragma unroll
        for (int ai = 0; ai < 2; ++ai)
#pragma unroll
            for (int m = 0; m < 4; ++m)
#pragma unroll
                for (int bj = 0; bj < 2; ++bj)
                    *(u32x4*)(base + (size_t)(ai * 128 + m * 16) * ldc + bj * 128) = pack8(acc[ai][bj][m][0] * scale, acc[ai][bj][m][1] * scale);
    }
};
struct EpiWin {
    static constexpr bool PERM = true, MIDK = false;
    bf16_t *QS, *KK, *VV, *GS, *XB, *GB; float* LF; const float* LB;
    __device__ __forceinline__ void operator()(Acc& acc, const Unit& u, int wr, int wc, int fr, int fq) const {
        const int seg = u.pn >> 2;
        const int col0 = (u.pn & 3) * 256 + wc * 32 + 8 * fq;
        const size_t row0 = (size_t)u.pm * 256 + wr * 64 + fr;
        bf16_t* dst = seg == 0 ? QS : seg == 1 ? KK : seg == 2 ? VV : seg == 3 ? GS : seg == 4 ? XB : GB;
#pragma unroll
        for (int bj = 0; bj < 2; ++bj) {
            const int col = col0 + bj * 128;
            f32x4 lb0 = (f32x4){0.f, 0.f, 0.f, 0.f}, lb1 = lb0;
            if (seg == 1) { lb0 = *(const f32x4*)(LB + col); lb1 = *(const f32x4*)(LB + col + 4); }
#pragma unroll
            for (int ai = 0; ai < 2; ++ai)
#pragma unroll
                for (int m = 0; m < 4; ++m) {
                    const size_t p = (row0 + ai * 128 + m * 16) * HW + col;
                    f32x4 v0 = acc[ai][bj][m][0], v1 = acc[ai][bj][m][1];
                    if (seg == 0 || seg == 3) {
#pragma unroll
                        for (int j = 0; j < 4; ++j) { v0[j] = siluf(v0[j]); v1[j] = siluf(v1[j]); }
                    } else if (seg == 1) {
                        f32x4 l0, l1;
#pragma unroll
                        for (int j = 0; j < 4; ++j) {
                            const float s0 = sigm(v0[j]), s1 = sigm(v1[j]);
                            l0[j] = __logf(lb0[j] + (1.f - lb0[j]) * s0); l1[j] = __logf(lb1[j] + (1.f - lb1[j]) * s1);
                            v0[j] = (1.f - lb0[j]) * (1.f - s0); v1[j] = (1.f - lb1[j]) * (1.f - s1);
                        }
                        *(f32x4*)(LF + p) = l0; *(f32x4*)(LF + p + 4) = l1;
                    } else if (seg == 5) {
#pragma unroll
                        for (int j = 0; j < 4; ++j) { v0[j] = gelu_tanh(v0[j]); v1[j] = gelu_tanh(v1[j]); }
                    }
                    *(u32x4*)(dst + p) = pack8(v0, v1);
                }
        }
    }
};
struct EpiGates {
    static constexpr bool PERM = true, MIDK = false;
    bf16_t* GAB; const float* bg;
    __device__ __forceinline__ void operator()(Acc& acc, const Unit& u, int wr, int wc, int fr, int fq) const {
        const int col0 = u.pn * 256 + wc * 32 + 8 * fq;
        const size_t row0 = (size_t)u.pm * 256 + wr * 64 + fr;
#pragma unroll
        for (int bj = 0; bj < 2; ++bj) {
            const int col = col0 + bj * 128;
            const f32x4 b0 = *(const f32x4*)(bg + col), b1 = *(const f32x4*)(bg + col + 4);
#pragma unroll
            for (int ai = 0; ai < 2; ++ai)
#pragma unroll
                for (int m = 0; m < 4; ++m) {
                    f32x4 v0 = acc[ai][bj][m][0] + b0, v1 = acc[ai][bj][m][1] + b1;
#pragma unroll
                    for (int j = 0; j < 4; ++j) { v0[j] = sigm(v0[j]); v1[j] = sigm(v1[j]); }
                    *(u32x4*)(GAB + (row0 + ai * 128 + m * 16) * 4096 + col) = pack8(v0, v1);
                }
        }
    }
};
template <int PASS> struct EpiMerge {
    static constexpr bool PERM = true, MIDK = false;
    const bf16_t* GAB; bf16_t* MG;
    __device__ __forceinline__ void operator()(Acc& acc, const Unit& u, int wr, int wc, int fr, int fq) const {
        const int col0 = u.pn * 256 + wc * 32 + 8 * fq;
        const size_t row0 = (size_t)u.pm * 256 + wr * 64 + fr;
#pragma unroll
        for (int ai = 0; ai < 2; ++ai)
#pragma unroll
            for (int m = 0; m < 4; ++m)
#pragma unroll
                for (int bj = 0; bj < 2; ++bj) {
                    const size_t r = row0 + ai * 128 + m * 16; const int col = col0 + bj * 128;
                    const u32x4 b = *(const u32x4*)(GAB + r * 4096 + PASS * 2048 + col);
                    f32x4 v0 = acc[ai][bj][m][0], v1 = acc[ai][bj][m][1];
                    v0[0] *= bflo(b.x); v0[1] *= bfhi(b.x); v0[2] *= bflo(b.y); v0[3] *= bfhi(b.y);
                    v1[0] *= bflo(b.z); v1[1] *= bfhi(b.z); v1[2] *= bflo(b.w); v1[3] *= bfhi(b.w);
                    if (PASS == 1) {
                        const u32x4 p = *(const u32x4*)(MG + r * D + col);
                        v0[0] += bflo(p.x); v0[1] += bfhi(p.x); v0[2] += bflo(p.y); v0[3] += bfhi(p.y);
                        v1[0] += bflo(p.z); v1[1] += bfhi(p.z); v1[2] += bflo(p.w); v1[3] += bfhi(p.w);
                    }
                    *(u32x4*)(MG + r * D + col) = pack8(v0, v1);
                }
    }
};
struct EpiSoftmax {
    static constexpr bool PERM = true, MIDK = false;
    bf16_t* P; LAS float* SM; LAS float* SS;
    __device__ __forceinline__ void operator()(Acc& acc, const Unit& u, int wr, int wc, int fr, int fq) const {
        float mx[2][4];
#pragma unroll
        for (int ai = 0; ai < 2; ++ai)
#pragma unroll
            for (int m = 0; m < 4; ++m) {
                float v = -3.0e38f;
#pragma unroll
                for (int bj = 0; bj < 2; ++bj)
#pragma unroll
                    for (int n = 0; n < 2; ++n)
#pragma unroll
                        for (int j = 0; j < 4; ++j) v = fmaxf(v, acc[ai][bj][m][n][j]);
                v = fmaxf(v, __shfl_xor(v, 16)); v = fmaxf(v, __shfl_xor(v, 32));
                if (fq == 0) SM[(ai * 128 + wr * 64 + m * 16 + fr) * 4 + wc] = v;
            }
        LDS_WAIT(); __builtin_amdgcn_s_barrier(); asm volatile("" ::: "memory");
#pragma unroll
        for (int ai = 0; ai < 2; ++ai)
#pragma unroll
            for (int m = 0; m < 4; ++m) {
                const f32x4 q = *(const LAS f32x4*)(SM + (ai * 128 + wr * 64 + m * 16 + fr) * 4);
                const float M = fmaxf(fmaxf(q[0], q[1]), fmaxf(q[2], q[3]));
                float s = 0.f;
#pragma unroll
                for (int bj = 0; bj < 2; ++bj)
#pragma unroll
                    for (int n = 0; n < 2; ++n)
#pragma unroll
                        for (int j = 0; j < 4; ++j) { const float e = __expf(acc[ai][bj][m][n][j] - M); acc[ai][bj][m][n][j] = e; s += e; }
                s += __shfl_xor(s, 16); s += __shfl_xor(s, 32);
                if (fq == 0) SS[(ai * 128 + wr * 64 + m * 16 + fr) * 4 + wc] = s;
            }
        LDS_WAIT(); __builtin_amdgcn_s_barrier(); asm volatile("" ::: "memory");
        bf16_t* base = P + u.ooff + (size_t)(wr * 64 + fr) * 1024 + wc * 32 + 8 * fq;
#pragma unroll
        for (int ai = 0; ai < 2; ++ai)
#pragma unroll
            for (int m = 0; m < 4; ++m) {
                const f32x4 q = *(const LAS f32x4*)(SS + (ai * 128 + wr * 64 + m * 16 + fr) * 4);
                const float inv = __builtin_amdgcn_rcpf((q[0] + q[1]) + (q[2] + q[3]));
#pragma unroll
                for (int bj = 0; bj < 2; ++bj)
                    *(u32x4*)(base + (size_t)(ai * 128 + m * 16) * 1024 + bj * 128) = pack8(acc[ai][bj][m][0] * inv, acc[ai][bj][m][1] * inv);
            }
    }
};
}

struct Args {
    const float* in[29]; float* out; unsigned char* ws; int ph_lo, ph_hi;
};

__device__ __forceinline__ void transpose_item(const float* W, int N, bf16_t* WT, int dstK, size_t drow0, int kdst0, int k0, int n0, LAS float* scr, int lane) {
#pragma unroll 8
    for (int i = 0; i < 32; ++i) { const int kk = 2 * i + (lane >> 5); scr[kk * 33 + (lane & 31)] = W[(size_t)(k0 + kk) * N + n0 + (lane & 31)]; }
    LDS_WAIT();
    const int c = lane & 7;
#pragma unroll
    for (int j = 0; j < 4; ++j) { const int n = (lane >> 3) + 8 * j; const LAS float* s = scr + (8 * c) * 33 + n;
        u32x4 o; o.x = cvt_pk_bf16(s[0 * 33], s[1 * 33]); o.y = cvt_pk_bf16(s[2 * 33], s[3 * 33]); o.z = cvt_pk_bf16(s[4 * 33], s[5 * 33]); o.w = cvt_pk_bf16(s[6 * 33], s[7 * 33]);
        *(u32x4*)(WT + (drow0 + n) * dstK + kdst0 + k0 + 8 * c) = o; }
    LDS_WAIT();
}
__device__ __forceinline__ void transpose_matrix(const float* W, int K, int N, bf16_t* WT, int dstK, int kdst0, int mode, LAS float* scr, int gw, int NGW, int lane) {
    const int nblk = N / 32, items = (K / 64) * nblk;
    for (int it = gw; it < items; it += NGW) {
        const int kb = it / nblk, nb = it % nblk, n0 = nb * 32;
        size_t drow0 = (size_t)n0;
        if (mode == 1) { const int half = n0 >= DFF ? 1 : 0, nn = n0 - half * DFF; drow0 = (size_t)(nn >> 7) * 256 + half * 128 + (nn & 127); }
        transpose_item(W, N, WT, dstK, drow0, kdst0, kb * 64, n0, scr, lane);
    }
}
__device__ __forceinline__ void rms_row_bf16(const float* xrow, const float* g, bf16_t* orow, int lane) {
    f32x4 v[8]; float s = 0.f;
#pragma unroll
    for (int j = 0; j < 8; ++j) { v[j] = __builtin_nontemporal_load((const f32x4*)xrow + lane + 64 * j); s += (v[j][0] * v[j][0] + v[j][1] * v[j][1]) + (v[j][2] * v[j][2] + v[j][3] * v[j][3]); }
    const float rstd = rsqrtf(wave_sum(s) * (1.f / D) + EPS);
#pragma unroll
    for (int j = 0; j < 8; ++j) { const f32x4 gg = ((const f32x4*)g)[lane + 64 * j]; u32x2 o; o.x = cvt_pk_bf16(v[j][0] * rstd * gg[0], v[j][1] * rstd * gg[1]); o.y = cvt_pk_bf16(v[j][2] * rstd * gg[2], v[j][3] * rstd * gg[3]);
        __builtin_nontemporal_store(o, (u32x2*)orow + lane + 64 * j); }
}
__device__ __forceinline__ void rms_row2_bf16(const float* xa, const float* xb, const float* g, bf16_t* oa, bf16_t* ob, int lane) {
    f32x4 va[8], vb[8]; float sa = 0.f, sb = 0.f;
#pragma unroll
    for (int j = 0; j < 8; ++j) { va[j] = __builtin_nontemporal_load((const f32x4*)xa + lane + 64 * j); vb[j] = __builtin_nontemporal_load((const f32x4*)xb + lane + 64 * j); }
#pragma unroll
    for (int j = 0; j < 8; ++j) { sa += (va[j][0] * va[j][0] + va[j][1] * va[j][1]) + (va[j][2] * va[j][2] + va[j][3] * va[j][3]); sb += (vb[j][0] * vb[j][0] + vb[j][1] * vb[j][1]) + (vb[j][2] * vb[j][2] + vb[j][3] * vb[j][3]); }
    const float ra = rsqrtf(wave_sum(sa) * (1.f / D) + EPS), rb = rsqrtf(wave_sum(sb) * (1.f / D) + EPS);
#pragma unroll
    for (int j = 0; j < 8; ++j) { const f32x4 gg = ((const f32x4*)g)[lane + 64 * j]; u32x2 o;
        o.x = cvt_pk_bf16(va[j][0] * ra * gg[0], va[j][1] * ra * gg[1]); o.y = cvt_pk_bf16(va[j][2] * ra * gg[2], va[j][3] * ra * gg[3]); __builtin_nontemporal_store(o, (u32x2*)oa + lane + 64 * j);
        o.x = cvt_pk_bf16(vb[j][0] * rb * gg[0], vb[j][1] * rb * gg[1]); o.y = cvt_pk_bf16(vb[j][2] * rb * gg[2], vb[j][3] * rb * gg[3]); __builtin_nontemporal_store(o, (u32x2*)ob + lane + 64 * j); }
}
__device__ __forceinline__ void norm_all_bf16(const float* src, const float* g, bf16_t* dst, int gw, int NGW, int lane) {
    int m = gw;
    for (; m + NGW < T; m += 2 * NGW) rms_row2_bf16(src + (size_t)m * D, src + (size_t)(m + NGW) * D, g, dst + (size_t)m * D, dst + (size_t)(m + NGW) * D, lane);
    for (; m < T; m += NGW) rms_row_bf16(src + (size_t)m * D, g, dst + (size_t)m * D, lane);
}
__device__ __forceinline__ void rms_row_f32(float* xrow, const float* g, int lane) {
    f32x4 v[8]; float s = 0.f;
#pragma unroll
    for (int j = 0; j < 8; ++j) { v[j] = __builtin_nontemporal_load((const f32x4*)xrow + lane + 64 * j); s += (v[j][0] * v[j][0] + v[j][1] * v[j][1]) + (v[j][2] * v[j][2] + v[j][3] * v[j][3]); }
    const float rstd = rsqrtf(wave_sum(s) * (1.f / D) + EPS);
#pragma unroll
    for (int j = 0; j < 8; ++j) { const f32x4 gg = ((const f32x4*)g)[lane + 64 * j]; __builtin_nontemporal_store(v[j] * rstd * gg, (f32x4*)xrow + lane + 64 * j); }
}

#define MFMA16(a, b, c) __builtin_amdgcn_mfma_f32_16x16x32_bf16((a), (b), (c), 0, 0, 0)
__device__ __forceinline__ void hgrn_item(LAS unsigned char* lds, int item, const bf16_t* QS, const float* LF, const bf16_t* KK, const bf16_t* VV, bf16_t* YAB) {
    const int tid = threadIdx.x, lane = tid & 63, wid = tid >> 6, l15 = lane & 15, quad = lane >> 4;
    const int b = item >> 4, h = (item >> 1) & 7, vh = item & 1;
    LAS bf16_t* QT = (LAS bf16_t*)(lds + 0);
    LAS bf16_t* KT = (LAS bf16_t*)(lds + 17408);
    LAS bf16_t* QH = (LAS bf16_t*)(lds + 34816);
    LAS bf16_t* KD = (LAS bf16_t*)(lds + 52224);
    LAS bf16_t* VT = (LAS bf16_t*)(lds + 70656);
    LAS bf16_t* PP = (LAS bf16_t*)(lds + 79872);
    LAS bf16_t* ST = (LAS bf16_t*)(lds + 89088);
    LAS float* DD = (LAS float*)(lds + 106496);
    LAS float* PS = (LAS float*)(lds + 107008);
    const int k = tid & 127, part = tid >> 7;
    const int vv = tid & 63, sg = tid >> 6;
    const size_t row0 = (size_t)b * SEQ;
    const int colq = h * 128 + k, colv = h * 128 + vh * 64 + vv;
    const int tt = wid >> 1, vt0 = (wid & 1) * 2;
    f32x4 S[4];
#pragma unroll
    for (int i = 0; i < 4; ++i) S[i] = (f32x4){0.f, 0.f, 0.f, 0.f};
    for (int i = tid; i < 64 * 136 / 2; i += NTHREADS) ((LAS unsigned*)ST)[i] = 0u;
    float lfv[16]; bf16_t qv[16], kv[16], vr[8];
#define HG_LOAD(c) do { const size_t r_ = row0 + (size_t)(c) * 64; \
        _Pragma("unroll") for (int i = 0; i < 16; ++i) { const size_t p_ = (r_ + part * 16 + i) * HW + colq; lfv[i] = LF[p_]; qv[i] = QS[p_]; kv[i] = KK[p_]; } \
        _Pragma("unroll") for (int i = 0; i < 8; ++i) vr[i] = VV[(r_ + sg * 8 + i) * HW + colv]; } while (0)
    HG_LOAD(0);
    for (int c = 0; c < 64; ++c) {
        float bl[16]; float run = 0.f;
#pragma unroll
        for (int i = 0; i < 16; ++i) { run += lfv[i]; bl[i] = run; }
        PS[part * 128 + k] = run;
        __syncthreads();
        const float p0 = PS[k], p1 = PS[128 + k], p2 = PS[256 + k], p3 = PS[384 + k];
        const float pre = part == 0 ? 0.f : part == 1 ? p0 : part == 2 ? p0 + p1 : p0 + p1 + p2;
        const float mref = p0 + p1, blast = (p0 + p1) + (p2 + p3);
        const float em = __expf(mref), ebm = __expf(blast - mref);
        float kd[16];
#pragma unroll
        for (int i = 0; i < 16; ++i) {
            const float bb = pre + bl[i];
            const float e1 = __expf(fminf(fmaxf(bb - mref, -80.f), 80.f)), e2 = __builtin_amdgcn_rcpf(e1);
            const float q = bf2f(qv[i]), kx = bf2f(kv[i]);
            const int s = part * 16 + i;
            QT[s * 136 + k] = f2bf(q * e1); KT[s * 136 + k] = f2bf(kx * e2); QH[s * 136 + k] = f2bf(q * e1 * em); kd[i] = kx * e2 * ebm;
        }
        { u32x4 w0, w1;
          w0.x = cvt_pk_bf16(kd[0], kd[1]); w0.y = cvt_pk_bf16(kd[2], kd[3]); w0.z = cvt_pk_bf16(kd[4], kd[5]); w0.w = cvt_pk_bf16(kd[6], kd[7]);
          w1.x = cvt_pk_bf16(kd[8], kd[9]); w1.y = cvt_pk_bf16(kd[10], kd[11]); w1.z = cvt_pk_bf16(kd[12], kd[13]); w1.w = cvt_pk_bf16(kd[14], kd[15]);
          *(LAS u32x4*)(KD + k * 72 + part * 16) = w0; *(LAS u32x4*)(KD + k * 72 + part * 16 + 8) = w1; }
        if (part == 0) DD[k] = em * ebm;
        { u32x4 w; w.x = (unsigned)vr[0] | ((unsigned)vr[1] << 16); w.y = (unsigned)vr[2] | ((unsigned)vr[3] << 16); w.z = (unsigned)vr[4] | ((unsigned)vr[5] << 16); w.w = (unsigned)vr[6] | ((unsigned)vr[7] << 16);
          *(LAS u32x4*)(VT + vv * 72 + sg * 8) = w; }
        __syncthreads();
        if (c + 1 < 64) HG_LOAD(c + 1);
        f32x4 acc_o[2];
        acc_o[0] = (f32x4){0.f, 0.f, 0.f, 0.f}; acc_o[1] = acc_o[0];
        {
            const int ti = wid >> 1;
#pragma unroll
            for (int q2 = 0; q2 < 2; ++q2) {
                const int si = (wid & 1) * 2 + q2;
                f32x4 a = (f32x4){0.f, 0.f, 0.f, 0.f};
                if (si <= ti) {
#pragma unroll
                    for (int ks = 0; ks < 4; ++ks) {
                        const bf16x8 af = *(const LAS bf16x8*)(QT + (ti * 16 + l15) * 136 + ks * 32 + quad * 8);
                        const bf16x8 bfr = *(const LAS bf16x8*)(KT + (si * 16 + l15) * 136 + ks * 32 + quad * 8);
                        a = MFMA16(af, bfr, a);
                    }
                }
#pragma unroll
                for (int j = 0; j < 4; ++j) { const int t = ti * 16 + quad * 4 + j, s = si * 16 + l15; PP[t * 72 + s] = f2bf((s <= t) ? a[j] : 0.f); }
            }
#pragma unroll
            for (int ks = 0; ks < 4; ++ks) {
                const bf16x8 af = *(const LAS bf16x8*)(QH + (tt * 16 + l15) * 136 + ks * 32 + quad * 8);
#pragma unroll
                for (int v2 = 0; v2 < 2; ++v2) {
                    const bf16x8 bfr = *(const LAS bf16x8*)(ST + ((vt0 + v2) * 16 + l15) * 136 + ks * 32 + quad * 8);
                    acc_o[v2] = MFMA16(af, bfr, acc_o[v2]);
                }
            }
        }
        __syncthreads();
#pragma unroll
        for (int ks = 0; ks < 2; ++ks) {
            const bf16x8 af = *(const LAS bf16x8*)(PP + (tt * 16 + l15) * 72 + ks * 32 + quad * 8);
#pragma unroll
            for (int v2 = 0; v2 < 2; ++v2) {
                const bf16x8 bfr = *(const LAS bf16x8*)(VT + ((vt0 + v2) * 16 + l15) * 72 + ks * 32 + quad * 8);
                acc_o[v2] = MFMA16(af, bfr, acc_o[v2]);
            }
        }
#pragma unroll
        for (int v2 = 0; v2 < 2; ++v2)
#pragma unroll
            for (int j = 0; j < 4; ++j) YAB[(row0 + (size_t)c * 64 + tt * 16 + quad * 4 + j) * D + h * 128 + vh * 64 + (vt0 + v2) * 16 + l15] = f2bf(acc_o[v2][j]);
        {
            const f32x4 dv = *(const LAS f32x4*)(DD + wid * 16 + quad * 4);
#pragma unroll
            for (int v4 = 0; v4 < 4; ++v4) S[v4] *= dv;
#pragma unroll
            for (int ks = 0; ks < 2; ++ks) {
                const bf16x8 af = *(const LAS bf16x8*)(KD + (wid * 16 + l15) * 72 + ks * 32 + quad * 8);
#pragma unroll
                for (int v4 = 0; v4 < 4; ++v4) {
                    const bf16x8 bfr = *(const LAS bf16x8*)(VT + (v4 * 16 + l15) * 72 + ks * 32 + quad * 8);
                    S[v4] = MFMA16(af, bfr, S[v4]);
                }
            }
#pragma unroll
            for (int v4 = 0; v4 < 4; ++v4) { u32x2 w; w.x = cvt_pk_bf16(S[v4][0], S[v4][1]); w.y = cvt_pk_bf16(S[v4][2], S[v4][3]); *(LAS u32x2*)(ST + (v4 * 16 + l15) * 136 + wid * 16 + quad * 4) = w; }
        }
    }
#undef HG_LOAD
    __syncthreads();
}

__device__ __forceinline__ void lru_item(LAS unsigned char* lds, int item, const bf16_t* XB, const bf16_t* GB, const float* conv_w, const float* conv_b, const bf16_t* WLA, const bf16_t* WLX,
                                         const float* ba, const float* bx, const float* lam, bf16_t* YAB) {
    const int tid = threadIdx.x, lane = tid & 63, wid = tid >> 6, l15 = lane & 15, quad = lane >> 4;
    const int b = item >> 4, n = (item >> 1) & 7, oh = item & 1;
    LAS bf16_t* XC = (LAS bf16_t*)(lds + 0);
    LAS bf16_t* WL = (LAS bf16_t*)(lds + 17408);
    LAS float* XCF = (LAS float*)(lds + 52224);
    LAS float* AA = XCF + 64 * 65;
    LAS float* UU = AA + 64 * 65;
    LAS float* GA = UU + 64 * 65;
    LAS float* GH = GA + 512;
    LAS float* HC = GH + 512;
    const int ch = tid & 127, part = tid >> 7;
    const int st = wid >> 1, ct0 = (wid & 1) * 2;
    const int cl = tid & 63, g = tid >> 6;
    const size_t row0 = (size_t)b * SEQ;
    const int colc = n * 128 + ch;
    const float w0 = conv_w[0 * HW + colc], w1 = conv_w[1 * HW + colc], w2 = conv_w[2 * HW + colc], w3 = conv_w[3 * HW + colc], cb = conv_b[colc];
    const bool own = (ch >> 6) == oh;
    for (int i = tid; i < 2048; i += NTHREADS) {
        const int mat = i >> 10, r = (i >> 4) & 63, kc = i & 15;
        const bf16_t* src = (mat ? WLX : WLA) + (size_t)(n * 128 + oh * 64 + r) * 128 + kc * 8;
        *(LAS u32x4*)(WL + (mat * 64 + r) * 136 + kc * 8) = *(const u32x4*)src;
    }
    float bav[2], bxv[2], lsl[2];
#pragma unroll
    for (int c2 = 0; c2 < 2; ++c2) { const int cp = n * 128 + oh * 64 + (ct0 + c2) * 16 + l15; bav[c2] = ba[cp]; bxv[c2] = bx[cp]; lsl[c2] = -log1pf(__expf(-lam[cp])); }
    const int colo = n * 128 + oh * 64 + cl;
    if (tid < 64) HC[tid] = 0.f;
    for (int c = 0; c < 64; ++c) {
        float xin[19];
        { const int t0 = c * 64 + part * 16;
#pragma unroll
          for (int i = 0; i < 19; ++i) { const int t = t0 - 3 + i; xin[i] = (t >= 0) ? bf2f(XB[(row0 + t) * HW + colc]) : 0.f; } }
        float gbv[8];
#pragma unroll
        for (int i = 0; i < 8; ++i) gbv[i] = bf2f(GB[(row0 + (size_t)c * 64 + g * 8 + i) * HW + colo]);
#pragma unroll
        for (int i = 0; i < 16; ++i) {
            const float xc = cb + w0 * xin[i + 3] + w1 * xin[i + 2] + w2 * xin[i + 1] + w3 * xin[i];
            XC[(part * 16 + i) * 136 + ch] = f2bf(xc);
            if (own) XCF[(part * 16 + i) * 65 + (ch & 63)] = xc;
        }
        __syncthreads();
        {
            f32x4 ar[2], ai[2];
            ar[0] = (f32x4){0.f, 0.f, 0.f, 0.f}; ar[1] = ar[0]; ai[0] = ar[0]; ai[1] = ar[0];
#pragma unroll
            for (int ks = 0; ks < 4; ++ks) {
                const bf16x8 af = *(const LAS bf16x8*)(XC + (st * 16 + l15) * 136 + ks * 32 + quad * 8);
#pragma unroll
                for (int c2 = 0; c2 < 2; ++c2) {
                    const bf16x8 fa = *(const LAS bf16x8*)(WL + ((ct0 + c2) * 16 + l15) * 136 + ks * 32 + quad * 8);
                    const bf16x8 fx = *(const LAS bf16x8*)(WL + (64 + (ct0 + c2) * 16 + l15) * 136 + ks * 32 + quad * 8);
                    ar[c2] = MFMA16(af, fa, ar[c2]); ai[c2] = MFMA16(af, fx, ai[c2]);
                }
            }
#pragma unroll
            for (int c2 = 0; c2 < 2; ++c2)
#pragma unroll
                for (int j = 0; j < 4; ++j) {
                    const int s = st * 16 + quad * 4 + j, cc = (ct0 + c2) * 16 + l15;
                    const float r = sigm(ar[c2][j] + bav[c2]), ig = sigm(ai[c2][j] + bxv[c2]);
                    const float la = 8.f * r * lsl[c2];
                    const float a = __expf(la);
                    float mult = sqrtf(fmaxf(-expm1f(2.f * la), 0.f));
                    if (c == 0 && s == 0) mult = 1.f;
                    AA[s * 65 + cc] = a; UU[s * 65 + cc] = XCF[s * 65 + cc] * ig * mult;
                }
        }
        __syncthreads();
        float a8[8], u8[8];
#pragma unroll
        for (int i = 0; i < 8; ++i) { a8[i] = AA[(g * 8 + i) * 65 + cl]; u8[i] = UU[(g * 8 + i) * 65 + cl]; }
        { float pa = 1.f, ph = 0.f;
#pragma unroll
          for (int i = 0; i < 8; ++i) { pa *= a8[i]; ph = a8[i] * ph + u8[i]; }
          GA[g * 64 + cl] = pa; GH[g * 64 + cl] = ph; }
        __syncthreads();
        float hh = HC[(c & 1) * 64 + cl];
        for (int g2 = 0; g2 < g; ++g2) hh = GA[g2 * 64 + cl] * hh + GH[g2 * 64 + cl];
#pragma unroll
        for (int i = 0; i < 8; ++i) { hh = a8[i] * hh + u8[i]; YAB[(row0 + (size_t)c * 64 + g * 8 + i) * D + HW + colo] = f2bf(DBG_YB_SCALE * hh * gbv[i]); }
        if (g == 7) HC[((c + 1) & 1) * 64 + cl] = hh;
    }
    __syncthreads();
}

#define XB_TMO      128
#define XB_XCNT(j)  (256  + 64 * (j))
#define XB_XSUB(j)  (1280 + 64 * (j))
#define XB_XGEN(j)  (2304 + 64 * (j))
#define XB_TOP      3328
#define XB_TOPGEN   3392
#define XCD_BAR_WORDS 3456
#define XB_SPIN_CAP (1u << 18)

__device__ __forceinline__ unsigned xb_ld(unsigned* p)              { return __hip_atomic_load(p, __ATOMIC_RELAXED, __HIP_MEMORY_SCOPE_AGENT); }
__device__ __forceinline__ unsigned xb_add(unsigned* p, unsigned v) { return __hip_atomic_fetch_add(p, v, __ATOMIC_RELAXED, __HIP_MEMORY_SCOPE_AGENT); }
__device__ __forceinline__ unsigned xb_xcc_id() { return (unsigned)__builtin_amdgcn_s_getreg((3 << 11) | 20) & 0xFu; }
#define XB_SPIN(cond, bar) do { unsigned _sp = 0; while (cond) { __builtin_amdgcn_s_sleep(1); \
    if ((++_sp & 255u) == 0u) { if (xb_ld(&(bar)[XB_TMO])) break; if (_sp > XB_SPIN_CAP) { atomicAdd(&(bar)[XB_TMO], 1u); break; } } } } while (0)

struct XcdBarrier {
    unsigned* bar; unsigned x;
    volatile LAS unsigned* st;
};

__device__ __forceinline__ XcdBarrier xcd_barrier_post(unsigned* bar, volatile LAS unsigned* st) {
    XcdBarrier b; b.bar = bar; b.x = xb_xcc_id(); b.st = st;
    if (threadIdx.x == 0) (void)xb_add(&bar[XB_XCNT(b.x)], 1u);
    return b;
}
__device__ __forceinline__ void xcd_barrier_complete(unsigned* bar, unsigned x, unsigned& nloc, unsigned& nx) {
    const unsigned G = gridDim.x * gridDim.y * gridDim.z;
    unsigned sum, cnt, mine, sp = 0u;
    for (;;) {
        sum = 0u; cnt = 0u; mine = 0u;
#pragma unroll
        for (unsigned j = 0; j < 16; ++j) { const unsigned c = xb_ld(&bar[XB_XCNT(j)]); sum += c; cnt += (c > 0u) ? 1u : 0u; mine = (j == x) ? c : mine; }
        if (sum == G) break;
        __builtin_amdgcn_s_sleep(1);
        if ((++sp & 255u) == 0u) { if (xb_ld(&bar[XB_TMO])) break; if (sp > XB_SPIN_CAP) { atomicAdd(&bar[XB_TMO], 1u); break; } }
    }
    nloc = mine > 0u ? mine : 1u; nx = cnt > 0u ? cnt : 1u;
}

__device__ __forceinline__ void xcd_barrier(const XcdBarrier& b) {
    asm volatile("s_waitcnt vmcnt(0)" ::: "memory");
    __syncthreads();
    if (threadIdx.x == 0) {
        unsigned* bar = b.bar;
        __builtin_amdgcn_s_waitcnt(0);
        unsigned nloc = b.st[0], nx = b.st[1];
        if (nloc == 0u) { xcd_barrier_complete(bar, b.x, nloc, nx); b.st[0] = nloc; b.st[1] = nx; }
        const unsigned old = xb_add(&bar[XB_XSUB(b.x)], 1u);
        const unsigned gen = old / nloc;
        if (old + 1u == (gen + 1u) * nloc) {
            __builtin_amdgcn_fence(__ATOMIC_RELEASE, "agent");
            asm volatile("s_waitcnt vmcnt(0)" ::: "memory");
            const unsigned og = xb_add(&bar[XB_TOP], 1u);
            const unsigned tg = og / nx;
            if (og + 1u == (tg + 1u) * nx) xb_add(&bar[XB_TOPGEN], 1u);
            else XB_SPIN(xb_ld(&bar[XB_TOPGEN]) == tg, bar);
            __builtin_amdgcn_fence(__ATOMIC_ACQUIRE, "agent");
            xb_add(&bar[XB_XGEN(b.x)], 1u);
            asm volatile("s_waitcnt vmcnt(0)" ::: "memory");
        } else {
            XB_SPIN(xb_ld(&bar[XB_XGEN(b.x)]) == gen, bar);
            __builtin_amdgcn_fence(__ATOMIC_ACQUIRE, "agent");
            asm volatile("s_waitcnt vmcnt(0)" ::: "memory");
        }
    }
    __syncthreads();
}

__global__ void __launch_bounds__(NTHREADS, 2) fwd_kernel(Args args) {
    extern __shared__ __attribute__((aligned(16))) unsigned char lds_raw[];
    LAS unsigned char* lds = (LAS unsigned char*)lds_raw;
    cg::grid_group grid = cg::this_grid();
    const int tid = threadIdx.x, lane = tid & 63, wave = __builtin_amdgcn_readfirstlane(tid >> 6);
    const int G = gridDim.x, bid = blockIdx.x;
    const int gw = bid * 8 + wave, NGW = G * 8;
    unsigned char* ws = args.ws;
    const float* x = args.in[0]; const float* mem = args.in[1];
    const float* ffn1_norm = args.in[2]; const float* ffn1_w_up = args.in[3]; const float* ffn1_w_down = args.in[4];
    const float* mix_norm = args.in[5]; const float* w_in = args.in[6]; const float* b_gate = args.in[7];
    const float* lb_logits = args.in[8]; const float* hgrn_norm = args.in[9];
    const float* conv_w = args.in[10]; const float* conv_b = args.in[11];
    const float* lru_wa = args.in[12]; const float* lru_ba = args.in[13]; const float* lru_wx = args.in[14]; const float* lru_bx = args.in[15]; const float* lru_lambda = args.in[16];
    const float* w_branch_a = args.in[17]; const float* w_branch_b = args.in[18]; const float* w_out = args.in[19];
    const float* xattn_norm = args.in[20]; const float* mem_norm = args.in[21]; const float* xattn_wq = args.in[22]; const float* xattn_wkv = args.in[23]; const float* xattn_wo = args.in[24];
    const float* ffn2_norm = args.in[25]; const float* ffn2_w_up = args.in[26]; const float* ffn2_w_down = args.in[27]; const float* final_norm = args.in[28];
    float* out = args.out;
    bf16_t* Wb = (bf16_t*)(ws + WS_W);
    bf16_t *WUP1 = Wb + E_WUP1, *WDN1 = Wb + E_WDN1, *WIN = Wb + E_WIN, *WAB = Wb + E_WAB, *WOUT = Wb + E_WOUT, *WQ = Wb + E_WQ, *WKV = Wb + E_WKV, *WO = Wb + E_WO,
           *WUP2 = Wb + E_WUP2, *WDN2 = Wb + E_WDN2, *WLA = Wb + E_WLA, *WLX = Wb + E_WLX;
    float* LB = (float*)(ws + WS_CTL);
    bf16_t* XN = (bf16_t*)(ws + WS_XN); bf16_t* YAB = (bf16_t*)(ws + WS_YAB); bf16_t* HB = (bf16_t*)(ws + WS_HB);
    bf16_t *QS = (bf16_t*)(ws + WS_QS), *KK = (bf16_t*)(ws + WS_KK), *VV = (bf16_t*)(ws + WS_VV), *GS = (bf16_t*)(ws + WS_GS), *XB = (bf16_t*)(ws + WS_XB), *GB = (bf16_t*)(ws + WS_GB);
    float* LF = (float*)(ws + WS_LF);
    bf16_t *GAB = (bf16_t*)(ws + WS_GAB), *MG = (bf16_t*)(ws + WS_MG), *Qb = (bf16_t*)(ws + WS_Q), *Pb = (bf16_t*)(ws + WS_P), *Ob = (bf16_t*)(ws + WS_O);
    bf16_t *KMAT = (bf16_t*)(ws + WS_KMAT), *VT = (bf16_t*)(ws + WS_VT), *MEMN = (bf16_t*)(ws + WS_MEMN);
    bf16_t *MTb = YAB, *NTb = YAB + (size_t)32 * 256 * D;

    const int lo = args.ph_lo, hi = args.ph_hi;
#ifndef DUP_MASK
#define DUP_MASK 0
#endif
#ifndef PH_MASK
#define PH_MASK 0x3ffff
#endif
#define IN(k) (((PH_MASK >> (k)) & 1) && lo <= (k) && (k) < hi)
#define SEAM(k) do { if (lo <= (k) && (k) + 1 < hi) { if ((k) == 0) { asm volatile("s_waitcnt vmcnt(0) lgkmcnt(0)" ::: "memory"); __syncthreads(); grid.sync(); \
        if (tid == 0) { __builtin_amdgcn_fence(__ATOMIC_ACQUIRE, "agent"); asm volatile("s_waitcnt vmcnt(0)" ::: "memory"); } __syncthreads(); } else { xcd_barrier(xbar); } } } while (0)
    volatile LAS unsigned* MISC = (volatile LAS unsigned*)(lds + STAGE_BYTES + 12288);
    if (tid < 4) MISC[tid] = 0u;
    __syncthreads();
    XcdBarrier xbar = xcd_barrier_post((unsigned*)(ws + WS_CTL + 131072), MISC);

    if (IN(0)) {
        LAS float* scr = (LAS float*)(lds + wave * 16384);
        transpose_matrix(ffn1_w_up, D, 2 * DFF, WUP1, D, 0, 1, scr, gw, NGW, lane);
        transpose_matrix(ffn1_w_down, DFF, D, WDN1, DFF, 0, 0, scr, gw, NGW, lane);
        transpose_matrix(w_in, D, 10240, WIN, D, 0, 0, scr, gw, NGW, lane);
        transpose_matrix(w_branch_a, HW, D, WAB, D, 0, 0, scr, gw, NGW, lane);
        transpose_matrix(w_branch_b, HW, D, WAB, D, HW, 0, scr, gw, NGW, lane);
        transpose_matrix(w_out, D, D, WOUT, D, 0, 0, scr, gw, NGW, lane);
        for (size_t i = ((size_t)gw * 64 + lane) * 8; i < (size_t)D * D; i += (size_t)NGW * 64 * 8)
            *(u32x4*)(WQ + i) = pg8::pack8(*(const f32x4*)(xattn_wq + i), *(const f32x4*)(xattn_wq + i + 4));
        transpose_matrix(xattn_wkv, D, 2 * D, WKV, D, 0, 0, scr, gw, NGW, lane);
        transpose_matrix(xattn_wo, D, D, WO, D, 0, 0, scr, gw, NGW, lane);
        transpose_matrix(ffn2_w_up, D, 2 * DFF, WUP2, D, 0, 1, scr, gw, NGW, lane);
        transpose_matrix(ffn2_w_down, DFF, D, WDN2, DFF, 0, 0, scr, gw, NGW, lane);
        for (int nb = 0; nb < 8; ++nb) {
            transpose_matrix(lru_wa + nb * 16384, 128, 128, WLA + nb * 16384, 128, 0, 0, scr, gw, NGW, lane);
            transpose_matrix(lru_wx + nb * 16384, 128, 128, WLX + nb * 16384, 128, 0, 0, scr, gw, NGW, lane);
        }
        norm_all_bf16(x, ffn1_norm, XN, gw, NGW, lane);
        for (int m = gw; m < NBATCH * NMEM; m += NGW) rms_row_bf16(mem + (size_t)m * D, mem_norm, MEMN + (size_t)m * D, lane);
        for (int i = bid * NTHREADS + tid; i < HW; i += G * NTHREADS) LB[i] = sigm(lb_logits[i] - lb_logits[HW + i]);
        __syncthreads();
    }
    SEAM(0);
    if (IN(1)) { pg8::StdOrder S; S.init(T, 2 * DFF, G, bid, D, D, DFF, 128); pg8::EpiSwiGLU E{HB}; pg8::gemm_phase(lds, XN, WUP1, D, D, D, S, E); }
    SEAM(1);
    if (IN(2)) { pg8::StdOrder S; S.init(T, D, G, bid, DFF, DFF, D, 256); pg8::EpiResid E{x, out, 0.5f}; pg8::gemm_phase(lds, HB, WDN1, DFF, DFF, DFF, S, E); }
    SEAM(2);
    if (IN(3)) {
        { pg8::StdOrder S; S.init(NBATCH * NMEM, D, G, bid, D, D, D, 256); pg8::EpiBf16 E{KMAT, D, 1.f}; pg8::gemm_phase(lds, MEMN, WKV, D, D, D, S, E); }
        { pg8::StdOrder S; S.init(NBATCH * NMEM, D, G, (bid + 64) % G, D, D, D, 256); pg8::EpiBf16 E{VT, D, 1.f}; pg8::gemm_phase(lds, MEMN, WKV + (size_t)D * D, D, D, D, S, E); }
        norm_all_bf16(out, mix_norm, XN, gw, NGW, lane);
    }
    SEAM(3);
    if (IN(4)) { pg8::StdOrder S; S.init(T, 6144, G, bid, D, D, HW, 256); pg8::EpiWin E{QS, KK, VV, GS, XB, GB, LF, LB}; pg8::gemm_phase(lds, XN, WIN, D, D, D, S, E); }
    SEAM(4);
    for (int rep_ = 0; rep_ < (((DUP_MASK >> 5) & 1) ? 2 : 1); ++rep_)
    if (IN(5)) {
        for (int it = bid; it < 256; it += G) {
            if (it < 128) hgrn_item(lds, it, QS, LF, KK, VV, YAB);
            else lru_item(lds, it - 128, XB, GB, conv_w, conv_b, WLA, WLX, lru_ba, lru_bx, lru_lambda, YAB);
        }
    }
    SEAM(5);
    if (IN(6)) {
        for (int m = gw; m < T; m += NGW) {
            bf16_t* orow = YAB + (size_t)m * D + lane * 16;
            const u32x4 a = *(const u32x4*)orow, b2 = *(const u32x4*)(orow + 8);
            float v[16] = {bflo(a.x), bfhi(a.x), bflo(a.y), bfhi(a.y), bflo(a.z), bfhi(a.z), bflo(a.w), bfhi(a.w), bflo(b2.x), bfhi(b2.x), bflo(b2.y), bfhi(b2.y), bflo(b2.z), bfhi(b2.z), bflo(b2.w), bfhi(b2.w)};
            float s = 0.f;
#pragma unroll
            for (int i = 0; i < 16; ++i) s += v[i] * v[i];
            s += __shfl_xor(s, 1); s += __shfl_xor(s, 2); s += __shfl_xor(s, 4);
            const float rstd = rsqrtf(s * (1.f / 128.f) + EPS);
            const bf16_t* grow = GS + (size_t)m * HW + lane * 16;
            const u32x4 ga = *(const u32x4*)grow, gb2 = *(const u32x4*)(grow + 8);
            const float gsv[16] = {bflo(ga.x), bfhi(ga.x), bflo(ga.y), bfhi(ga.y), bflo(ga.z), bfhi(ga.z), bflo(ga.w), bfhi(ga.w), bflo(gb2.x), bfhi(gb2.x), bflo(gb2.y), bfhi(gb2.y), bflo(gb2.z), bfhi(gb2.z), bflo(gb2.w), bfhi(gb2.w)};
            const float* hn = hgrn_norm + lane * 16;
#pragma unroll
            for (int i = 0; i < 16; ++i) v[i] = v[i] * rstd * hn[i] * gsv[i];
            u32x4 o0, o1;
            o0.x = cvt_pk_bf16(v[0], v[1]); o0.y = cvt_pk_bf16(v[2], v[3]); o0.z = cvt_pk_bf16(v[4], v[5]); o0.w = cvt_pk_bf16(v[6], v[7]);
            o1.x = cvt_pk_bf16(v[8], v[9]); o1.y = cvt_pk_bf16(v[10], v[11]); o1.z = cvt_pk_bf16(v[12], v[13]); o1.w = cvt_pk_bf16(v[14], v[15]);
            *(u32x4*)orow = o0; *(u32x4*)(orow + 8) = o1;
        }
        __syncthreads();
        { pg8::StdOrder S; S.init(T, 4096, G, bid, D, D, 4096, 256); pg8::EpiGates E{GAB, b_gate}; pg8::gemm_phase(lds, XN, WIN + (size_t)6144 * D, D, D, D, S, E); }
    }
    SEAM(6);
    if (IN(7)) {
        pg8::StdOrder S; S.init(T, D, G, bid, D, D, D, 256);
        { pg8::EpiMerge<0> E{GAB, MG}; pg8::gemm_phase(lds, YAB, WAB, HW, D, D, S, E); }
        { pg8::EpiMerge<1> E{GAB, MG}; pg8::gemm_phase(lds, YAB + HW, WAB + HW, HW, D, D, S, E); }
    }
    SEAM(7);
    if (IN(8)) { pg8::StdOrder S; S.init(T, D, G, bid, D, D, D, 256); pg8::EpiResid E{out, out, 1.f}; pg8::gemm_phase(lds, MG, WOUT, D, D, D, S, E); }
    SEAM(8);
    if (IN(9)) {
        { pg8::MtOrder S{G, bid}; pg8::EpiBf16 E{MTb, D, 0.044194173824159216f}; pg8::gemm_phase<pg8::EpiBf16, pg8::MtOrder, false, false>(lds, KMAT, WQ, XD, D, D, S, E); }
        { pg8::NtOrder S{G, bid}; pg8::EpiBf16 E{NTb, 1024, 1.f}; pg8::gemm_phase<pg8::EpiBf16, pg8::NtOrder, false, false>(lds, WO, VT, XD, D, D, S, E); }
        norm_all_bf16(out, xattn_norm, XN, gw, NGW, lane);
    }
    SEAM(9);
    if (IN(11)) { pg8::ScoreOrder S{G, bid}; pg8::EpiSoftmax E{Pb, (LAS float*)(lds + STAGE_BYTES), (LAS float*)(lds + STAGE_BYTES + 4096)}; pg8::gemm_phase<pg8::EpiSoftmax, pg8::ScoreOrder, false, false>(lds, XN, MTb, D, D, D, S, E); }
    SEAM(11);
    if (IN(13)) { pg8::OutOrder S; S.init(T, D, G, bid, 1024, 1024, D, 256); pg8::EpiResid E{out, out, 1.f}; pg8::gemm_phase(lds, Pb, NTb, 1024, 1024, 1024, S, E); }
    SEAM(13);
    if (IN(14)) { norm_all_bf16(out, ffn2_norm, XN, gw, NGW, lane); }
    SEAM(14);
    if (IN(15)) { pg8::StdOrder S; S.init(T, 2 * DFF, G, bid, D, D, DFF, 128); pg8::EpiSwiGLU E{HB}; pg8::gemm_phase(lds, XN, WUP2, D, D, D, S, E); }
    SEAM(15);
    if (IN(16)) { pg8::StdOrder S; S.init(T, D, G, bid, DFF, DFF, D, 256); pg8::EpiResid E{out, out, 0.5f}; pg8::gemm_phase(lds, HB, WDN2, DFF, DFF, DFF, S, E); }
    SEAM(16);
    if (IN(17)) { for (int m = gw; m < T; m += NGW) rms_row_f32(out + (size_t)m * D, final_norm, lane); }
#undef IN
#undef SEAM
}

constexpr int N_PHASES = 18;

extern "C" void kernel_launch(void* const* d_in, const int* in_sizes, int n_in, void* d_out, int out_size, void* d_ws, size_t ws_size, hipStream_t stream) {
    static int grid = 0;
    if (grid == 0) {
        if (n_in != 29 || out_size != T * D || ws_size < WS_END) { fprintf(stderr, "kernel_launch: unexpected shapes (n_in %d, out %d, ws %zu)\n", n_in, out_size, ws_size); grid = -1; return; }
        int dev = 0, cus = 0, per_cu = 0;
        (void)hipGetDevice(&dev);
        (void)hipDeviceGetAttribute(&cus, hipDeviceAttributeMultiprocessorCount, dev);
        if (hipFuncSetAttribute((const void*)fwd_kernel, hipFuncAttributeMaxDynamicSharedMemorySize, LDS_BYTES) != hipSuccess) { fprintf(stderr, "kernel_launch: hipFuncSetAttribute failed\n"); grid = -1; return; }
        if (hipOccupancyMaxActiveBlocksPerMultiprocessor(&per_cu, (const void*)fwd_kernel, NTHREADS, LDS_BYTES) != hipSuccess || per_cu < 1) { fprintf(stderr, "kernel_launch: occupancy query gave %d\n", per_cu); per_cu = 1; }
        (void)hipGetLastError();
        grid = cus * 1;
        if (grid <= 0) grid = 256;
    }
    if (grid < 0) return;
    (void)hipMemsetAsync((char*)d_ws + WS_CTL + 131072, 0, 16384, stream);
    Args a{};
    for (int i = 0; i < 29; ++i) a.in[i] = (const float*)d_in[i];
    a.out = (float*)d_out; a.ws = (unsigned char*)d_ws; a.ph_lo = 0; a.ph_hi = N_PHASES;
    void* kargs[] = {&a};
    hipError_t e = hipLaunchCooperativeKernel((const void*)fwd_kernel, dim3(grid), dim3(NTHREADS), kargs, LDS_BYTES, stream);
    if (e != hipSuccess) fprintf(stderr, "kernel_launch: cooperative launch failed: %s (grid %d)\n", hipGetErrorString(e), grid);
}
```

```cpp
#ifndef DBG_YB_SCALE
#define DBG_YB_SCALE 1.f
#endif
#include <hip/hip_runtime.h>
#include <hip/hip_cooperative_groups.h>
#include <cstdio>
#include <cstdint>
namespace cg = cooperative_groups;

#define LAS __attribute__((address_space(3)))
typedef unsigned short bf16_t;
typedef short bf16x8 __attribute__((ext_vector_type(8)));
typedef float f32x4 __attribute__((ext_vector_type(4)));
typedef unsigned u32x4 __attribute__((ext_vector_type(4)));
typedef unsigned u32x2 __attribute__((ext_vector_type(2)));

constexpr int T = 32768, D = 2048, DFF = 5632, NBATCH = 8, SEQ = 4096, HW = 1024, NMEM = 256, XH = 4, XD = 512;
constexpr float EPS = 1e-6f;
constexpr int NTHREADS = 512;
constexpr int STAGE_BYTES = 131072, LDS_BYTES = STAGE_BYTES + 16384;

constexpr size_t MiB = 1ull << 20;
constexpr size_t WS_CTL = 0;
constexpr size_t WS_W = 1 * MiB;
constexpr size_t E_WUP1 = 0, E_WDN1 = E_WUP1 + 23068672ull, E_WIN = E_WDN1 + 11534336ull, E_WAB = E_WIN + 20971520ull, E_WOUT = E_WAB + 4194304ull,
                 E_WQ = E_WOUT + 4194304ull, E_WKV = E_WQ + 4194304ull, E_WO = E_WKV + 8388608ull, E_WUP2 = E_WO + 4194304ull, E_WDN2 = E_WUP2 + 23068672ull,
                 E_WLA = E_WDN2 + 11534336ull, E_WLX = E_WLA + 131072ull, E_WEND = E_WLX + 131072ull;
static_assert(E_WEND * 2 <= 221 * MiB, "weights region");
constexpr size_t WS_XN = 222 * MiB;
constexpr size_t WS_YAB = 350 * MiB;
constexpr size_t WS_BIG = 478 * MiB;
constexpr size_t WS_HB = WS_BIG;
constexpr size_t WS_QS = WS_BIG, WS_KK = WS_BIG + 64 * MiB, WS_VV = WS_BIG + 128 * MiB, WS_GS = WS_BIG + 192 * MiB, WS_XB = WS_BIG + 256 * MiB,
                 WS_GB = WS_BIG + 320 * MiB, WS_LF = WS_BIG + 384 * MiB;
constexpr size_t WS_GAB = WS_BIG + 256 * MiB;
constexpr size_t WS_MG = WS_BIG;
constexpr size_t WS_Q = WS_BIG + 128 * MiB;
constexpr size_t WS_P = WS_BIG + 256 * MiB;
constexpr size_t WS_O = WS_BIG + 320 * MiB;
constexpr size_t WS_KMAT = WS_BIG + 512 * MiB;
constexpr size_t WS_VT = WS_BIG + 520 * MiB;
constexpr size_t WS_MEMN = WS_BIG + 528 * MiB;
constexpr size_t WS_END = WS_BIG + 536 * MiB;
static_assert(WS_END <= 1024 * MiB, "workspace");

typedef float f32x2_c __attribute__((ext_vector_type(2)));
typedef __bf16 bf16x2_c __attribute__((ext_vector_type(2)));
__device__ __forceinline__ unsigned cvt_pk_bf16(float lo, float hi) { f32x2_c v = {lo, hi}; bf16x2_c r = __builtin_convertvector(v, bf16x2_c); return __builtin_bit_cast(unsigned, r); }
__device__ __forceinline__ bf16_t f2bf(float f) { return (bf16_t)(cvt_pk_bf16(f, 0.f) & 0xffffu); }
__device__ __forceinline__ float bf2f(bf16_t b) { return __uint_as_float(((unsigned)b) << 16); }
__device__ __forceinline__ float bflo(unsigned w) { return __uint_as_float(w << 16); }
__device__ __forceinline__ float bfhi(unsigned w) { return __uint_as_float(w & 0xffff0000u); }
__device__ __forceinline__ float sigm(float x) { return __builtin_amdgcn_rcpf(1.f + __expf(-x)); }
__device__ __forceinline__ float siluf(float x) { return x * sigm(x); }
__device__ __forceinline__ float gelu_tanh(float x) { return x * sigm(1.5957691216f * (x + 0.044715f * x * x * x)); }
__device__ __forceinline__ float wave_sum(float v) {
#pragma unroll
    for (int o = 1; o < 64; o <<= 1) v += __shfl_xor(v, o);
    return v;
}
#define LDS_WAIT() asm volatile("s_waitcnt lgkmcnt(0)" ::: "memory")

namespace pg8 {
constexpr int BM = 256, BK = 64, HALF = 128, HTB = HALF * BK * 2, NXCD = 8, WGM = 8;
__host__ __device__ __forceinline__ int lds_byte(int r, int c) { const int st = (r >> 4) * 2 + (c >> 5), rr = r & 15, cc = c & 31, ob = rr * 64 + cc * 2; return st * 1024 + (ob ^ (((ob >> 9) & 1) << 5)); }
__host__ __device__ __forceinline__ void stage_rc(int b, int& R, int& C) { const int st = b / 1024, sb = b % 1024, swz = sb ^ (((sb >> 9) & 1) << 5); R = (st >> 1) * 16 + swz / 64; C = (st & 1) * 32 + (swz % 64) / 2; }
__host__ __device__ __forceinline__ int perm32(int rho) { const int n = rho >> 4, i = rho & 15; return 8 * (i >> 2) + 4 * n + (i & 3); }

struct Unit { int pm, pn; size_t aoff, boff, ooff; };

struct StdOrder {
    int nM, nN, nwg, G, c; size_t ta, tb, ldc; int ocols;
    __device__ void init(int M, int N, int G_, int c_, int lda, int ldb, int ldc_, int ocols_) { nM = M / BM; nN = N / BM; nwg = nM * nN; G = G_; c = c_; ta = (size_t)BM * lda * 2; tb = (size_t)BM * ldb * 2; ldc = (size_t)ldc_; ocols = ocols_; }
    __device__ bool next(int i, Unit& u) const {
        const long L = (long)i * G + c; if (L >= nwg) return false;
        int wgid = (int)L; { const int q = nwg / NXCD, r = nwg % NXCD, xcd = wgid % NXCD, off = wgid / NXCD; wgid = (xcd < r ? xcd * (q + 1) : r * (q + 1) + (xcd - r) * q) + off; }
        const int nig = WGM * nN, gid = wgid / nig, fm = gid * WGM, gsz = (nM - fm) < WGM ? (nM - fm) : WGM;
        u.pm = fm + ((wgid % nig) % gsz); u.pn = (wgid % nig) / gsz;
        u.aoff = (size_t)u.pm * ta; u.boff = (size_t)u.pn * tb; u.ooff = (size_t)u.pm * BM * ldc + (size_t)u.pn * ocols; return true;
    }
};
struct MtOrder {
    int G, c;
    __device__ bool next(int i, Unit& u) const {
        const int L = i * G + c; if (L >= 256) return false;
        const int nt = L & 7, bh = L >> 3, b = bh >> 2, h = bh & 3;
        u.pm = bh; u.pn = nt;
        u.aoff = ((size_t)(b * NMEM) * D + (size_t)h * XD) * 2; u.boff = ((size_t)(nt * 256) * D + (size_t)h * XD) * 2; u.ooff = (size_t)bh * 256 * D + (size_t)nt * 256; return true;
    }
};
struct NtOrder {
    int G, c;
    __device__ bool next(int i, Unit& u) const {
        const int L = i * G + c; if (L >= 256) return false;
        const int mt = L & 7, bh = L >> 3, b = bh >> 2, h = bh & 3;
        u.pm = mt; u.pn = bh;
        u.aoff = ((size_t)(mt * 256) * D + (size_t)h * XD) * 2; u.boff = ((size_t)(b * NMEM) * D + (size_t)h * XD) * 2; u.ooff = (size_t)b * D * 1024 + (size_t)(mt * 256) * 1024 + (size_t)h * 256; return true;
    }
};
struct ScoreOrder {
    int G, c;
    __device__ bool next(int i, Unit& u) const {
        const int L = i * G + c; if (L >= NBATCH * XH * 16) return false;
        const int qt = L & 15, h = (L >> 4) & 3, b = L >> 6;
        u.pm = L; u.pn = 0;
        u.aoff = (size_t)(b * SEQ + qt * 256) * D * 2; u.boff = (size_t)(b * XH + h) * 256 * D * 2; u.ooff = (size_t)(b * SEQ + qt * 256) * 1024 + (size_t)h * 256; return true;
    }
};
struct OutOrder : StdOrder {
    __device__ bool next(int i, Unit& u) const {
        if (!StdOrder::next(i, u)) return false;
        u.boff += (size_t)(u.pm >> 4) * D * 1024 * 2; return true;
    }
};

template <class Epi, class Sched, bool ALIGN_EPI = true, bool SP2 = true>
__device__ __forceinline__ void gemm_phase(LAS unsigned char* lds, const bf16_t* Ag, const bf16_t* Btg, const int K, const int lda, const int ldb, const Sched& S, const Epi& E) {
    const int tid = threadIdx.x, wid = __builtin_amdgcn_readfirstlane(tid >> 6), lane = tid & 63, wr = wid >> 2, wc = wid & 3, fr = lane & 15, fq = lane >> 4;
    const int nt = K / BK;
    unsigned voffA[2], voffB[2];
#pragma unroll
    for (int i = 0; i < 2; ++i) { int R, C; stage_rc(tid * 16 + i * 8192, R, C); const int Rb = Epi::PERM ? ((R & ~31) + perm32(R & 31)) : R;
        voffA[i] = (unsigned)(R * lda + C) * 2u; voffB[i] = (unsigned)(Rb * ldb + C) * 2u; }
    const size_t kstep = (size_t)(BK * 2);
    const size_t hstepA = (size_t)HALF * lda * 2, hstepB = (size_t)HALF * ldb * 2;
    const unsigned ldsw = (unsigned)wid * 1024u;
    const int aoff = lds_byte(wr * 64 + fr, fq * 8), boff = lds_byte(wc * 32 + fr, fq * 8);
#define PG8_SA(b, h) (((b) * 2 + (h)) * HTB)
#define PG8_SB(b, h) ((4 + (b) * 2 + (h)) * HTB)
#define PG8_STAGE(bufoff, gbase, voff) do { _Pragma("unroll") for (int _i = 0; _i < 2; ++_i) \
        __builtin_amdgcn_global_load_lds((const unsigned*)((const char*)(gbase) + (voff)[_i]), (LAS unsigned*)(lds + (bufoff) + ldsw + _i * 8192), 16, 0, 0); } while (0)
#define PG8_LDA(dst, b, h) do { _Pragma("unroll") for (int m = 0; m < 4; ++m) _Pragma("unroll") for (int k = 0; k < 2; ++k) dst[m][k] = *(const LAS bf16x8*)(lds + PG8_SA(b, h) + aoff + m * 2048 + k * 1024); } while (0)
#define PG8_LDB(dst, b, h) do { _Pragma("unroll") for (int n = 0; n < 2; ++n) _Pragma("unroll") for (int k = 0; k < 2; ++k) dst[n][k] = *(const LAS bf16x8*)(lds + PG8_SB(b, h) + boff + n * 2048 + k * 1024); } while (0)
#define PG8_MMA(ai, bj, At, Bt) do { __builtin_amdgcn_s_setprio(1); _Pragma("unroll") for (int m = 0; m < 4; ++m) _Pragma("unroll") for (int n = 0; n < 2; ++n) _Pragma("unroll") for (int k = 0; k < 2; ++k) \
        acc[ai][bj][m][n] = __builtin_amdgcn_mfma_f32_16x16x32_bf16(Bt[n][k], At[m][k], acc[ai][bj][m][n], 0, 0, 0); __builtin_amdgcn_s_setprio(0); } while (0)
#define PG8_WAIT_V(n) asm volatile("s_waitcnt vmcnt(" #n ")" ::: "memory")
#define PG8_WAIT_L(n) asm volatile("s_waitcnt lgkmcnt(" #n ")" ::: "memory")
#define PG8_BAR __builtin_amdgcn_s_barrier()
#define PG8_SCHED __builtin_amdgcn_sched_barrier(0)
    Unit cur, nxt; int ui = 0;
    if (!S.next(0, cur)) return;
    f32x4 acc[2][2][4][2];
#pragma unroll
    for (int a = 0; a < 2; ++a)
#pragma unroll
        for (int b = 0; b < 2; ++b)
#pragma unroll
            for (int m = 0; m < 4; ++m)
#pragma unroll
                for (int n = 0; n < 2; ++n) acc[a][b][m][n] = (f32x4){0.f, 0.f, 0.f, 0.f};
    bf16x8 At[4][2], B0[2][2], B1[2][2];
    const char* cA = (const char*)Ag + cur.aoff; const char* cB = (const char*)Btg + cur.boff;
    if constexpr (SP2) {
        PG8_STAGE(PG8_SB(0, 0), cB, voffB); PG8_STAGE(PG8_SB(0, 1), cB + hstepB, voffB); PG8_STAGE(PG8_SA(0, 0), cA, voffA); PG8_STAGE(PG8_SA(0, 1), cA + hstepA, voffA);
        if (wr == 1) PG8_BAR;
        PG8_WAIT_V(2); PG8_BAR;
        PG8_STAGE(PG8_SB(1, 0), cB + kstep, voffB); PG8_STAGE(PG8_SA(1, 0), cA + kstep, voffA); PG8_STAGE(PG8_SB(1, 1), cB + hstepB + kstep, voffB);
        PG8_WAIT_V(6); PG8_BAR;
    } else {
    PG8_STAGE(PG8_SB(0, 0), cB, voffB); PG8_STAGE(PG8_SA(0, 0), cA, voffA); PG8_STAGE(PG8_SB(0, 1), cB + hstepB, voffB); PG8_STAGE(PG8_SA(0, 1), cA + hstepA, voffA);
    if (wr == 1) PG8_BAR;
    PG8_WAIT_V(4); PG8_BAR;
    PG8_STAGE(PG8_SB(1, 0), cB + kstep, voffB); PG8_STAGE(PG8_SA(1, 0), cA + kstep, voffA); PG8_STAGE(PG8_SB(1, 1), cB + hstepB + kstep, voffB);
    PG8_WAIT_V(6); PG8_BAR;
    }
    for (;;) {
        const bool has_next = S.next(ui + 1, nxt);
        const char* nA = has_next ? (const char*)Ag + nxt.aoff : cA; const char* nB = has_next ? (const char*)Btg + nxt.boff : cB;
        for (int t = 0; t < nt; t += 2) {
            const bool last = (t == nt - 2);
            const char* a1 = cA + (size_t)(t + 1) * kstep;
            const char* a2 = last ? nA : cA + (size_t)(t + 2) * kstep; const char* b2 = last ? nB : cB + (size_t)(t + 2) * kstep;
            const char* a3 = a2 + kstep; const char* b3 = b2 + kstep;
            if constexpr (SP2) {
            PG8_LDB(B0, 0, 0); PG8_LDB(B1, 0, 1); PG8_SCHED; PG8_LDA(At, 0, 0); PG8_STAGE(PG8_SA(1, 1), a1 + hstepA, voffA);
            PG8_WAIT_V(8); PG8_WAIT_L(0); PG8_BAR; PG8_MMA(0, 0, At, B0); PG8_MMA(0, 1, At, B1); PG8_BAR; PG8_SCHED;
            PG8_LDA(At, 0, 1); PG8_STAGE(PG8_SB(0, 0), b2, voffB); PG8_STAGE(PG8_SB(0, 1), b2 + hstepB, voffB); PG8_STAGE(PG8_SA(0, 0), a2, voffA);
            PG8_WAIT_V(8); PG8_WAIT_L(0); PG8_BAR; PG8_MMA(1, 0, At, B0); PG8_MMA(1, 1, At, B1); PG8_BAR; PG8_SCHED;
            PG8_LDB(B0, 1, 0); PG8_LDB(B1, 1, 1); PG8_SCHED; PG8_LDA(At, 1, 0); PG8_STAGE(PG8_SA(0, 1), a2 + hstepA, voffA);
            PG8_WAIT_V(8); PG8_WAIT_L(0); PG8_BAR; PG8_MMA(0, 0, At, B0); PG8_MMA(0, 1, At, B1); PG8_BAR; PG8_SCHED;
            PG8_LDA(At, 1, 1); PG8_STAGE(PG8_SB(1, 0), b3, voffB); PG8_STAGE(PG8_SB(1, 1), b3 + hstepB, voffB); PG8_STAGE(PG8_SA(1, 0), a3, voffA);
            PG8_WAIT_V(8); PG8_WAIT_L(0); PG8_BAR; PG8_MMA(1, 0, At, B0); PG8_MMA(1, 1, At, B1); PG8_BAR; PG8_SCHED;
            } else {
            PG8_LDB(B0, 0, 0); PG8_SCHED; PG8_LDA(At, 0, 0); PG8_STAGE(PG8_SA(1, 1), a1 + hstepA, voffA);
            PG8_WAIT_L(8); PG8_BAR; PG8_WAIT_L(0); PG8_MMA(0, 0, At, B0); PG8_BAR; PG8_SCHED;
            PG8_LDB(B1, 0, 1); PG8_STAGE(PG8_SB(0, 0), b2, voffB);
            PG8_BAR; PG8_WAIT_L(0); PG8_MMA(0, 1, At, B1); PG8_BAR;
            PG8_LDA(At, 0, 1); PG8_STAGE(PG8_SA(0, 0), a2, voffA);
            PG8_BAR; PG8_WAIT_L(0); PG8_MMA(1, 0, At, B0); PG8_BAR; PG8_SCHED;
            PG8_STAGE(PG8_SB(0, 1), b2 + hstepB, voffB);
            PG8_WAIT_V(6); PG8_BAR; PG8_MMA(1, 1, At, B1); PG8_BAR;
            PG8_LDB(B0, 1, 0); PG8_SCHED; PG8_LDA(At, 1, 0); PG8_STAGE(PG8_SA(0, 1), a2 + hstepA, voffA);
            PG8_WAIT_L(8); PG8_BAR; PG8_WAIT_L(0); PG8_MMA(0, 0, At, B0); PG8_BAR; PG8_SCHED;
            PG8_LDB(B1, 1, 1); PG8_STAGE(PG8_SB(1, 0), b3, voffB);
            PG8_BAR; PG8_WAIT_L(0); PG8_MMA(0, 1, At, B1); PG8_BAR;
            PG8_LDA(At, 1, 1); PG8_STAGE(PG8_SA(1, 0), a3, voffA);
            PG8_BAR; PG8_WAIT_L(0); PG8_MMA(1, 0, At, B0); PG8_BAR; PG8_SCHED;
            PG8_STAGE(PG8_SB(1, 1), b3 + hstepB, voffB);
            PG8_WAIT_V(6); PG8_BAR; PG8_MMA(1, 1, At, B1); PG8_BAR;
            }
        }
        if constexpr (ALIGN_EPI) { if (wr == 0) PG8_BAR; }
        E(acc, cur, wr, wc, fr, fq);
        if (!has_next) break;
#pragma unroll
        for (int a = 0; a < 2; ++a)
#pragma unroll
            for (int b = 0; b < 2; ++b)
#pragma unroll
                for (int m = 0; m < 4; ++m)
#pragma unroll
                    for (int n = 0; n < 2; ++n) acc[a][b][m][n] = (f32x4){0.f, 0.f, 0.f, 0.f};
        cur = nxt; cA = nA; cB = nB; ++ui;
        if constexpr (ALIGN_EPI) { if (wr == 1) PG8_BAR; }
    }
    PG8_WAIT_V(0);
    if constexpr (!ALIGN_EPI) { if (wr == 0) PG8_BAR; }
    PG8_BAR;
#undef PG8_SA
#undef PG8_SB
#undef PG8_STAGE
#undef PG8_LDA
#undef PG8_LDB
#undef PG8_MMA
#undef PG8_WAIT_V
#undef PG8_WAIT_L
#undef PG8_BAR
#undef PG8_SCHED
}

typedef f32x4 Acc[2][2][4][2];
__device__ __forceinline__ u32x4 pack8(const f32x4 a, const f32x4 b) { u32x4 w; w.x = cvt_pk_bf16(a[0], a[1]); w.y = cvt_pk_bf16(a[2], a[3]); w.z = cvt_pk_bf16(b[0], b[1]); w.w = cvt_pk_bf16(b[2], b[3]); return w; }

struct EpiSwiGLU {
    static constexpr bool PERM = true, MIDK = false;
    bf16_t* H;
    __device__ __forceinline__ void operator()(Acc& acc, const Unit& u, int wr, int wc, int fr, int fq) const {
        bf16_t* base = H + u.ooff + (size_t)(wr * 64 + fr) * DFF + wc * 32 + 8 * fq;
#pragma unroll
        for (int ai = 0; ai < 2; ++ai)
#pragma unroll
            for (int m = 0; m < 4; ++m) {
                f32x4 h0, h1;
#pragma unroll
                for (int j = 0; j < 4; ++j) { h0[j] = siluf(acc[ai][0][m][0][j]) * acc[ai][1][m][0][j]; h1[j] = siluf(acc[ai][0][m][1][j]) * acc[ai][1][m][1][j]; }
                *(u32x4*)(base + (size_t)(ai * 128 + m * 16) * DFF) = pack8(h0, h1);
            }
    }
};
struct EpiResid {
    static constexpr bool PERM = true, MIDK = false;
    const float* R; float* O; float scale;
    __device__ __forceinline__ void operator()(Acc& acc, const Unit& u, int wr, int wc, int fr, int fq) const {
        const size_t p0 = u.ooff + (size_t)(wr * 64 + fr) * D + wc * 32 + 8 * fq;
#pragma unroll
        for (int ai = 0; ai < 2; ++ai)
#pragma unroll
            for (int m = 0; m < 4; ++m)
#pragma unroll
                for (int bj = 0; bj < 2; ++bj) {
                    const size_t p = p0 + (size_t)(ai * 128 + m * 16) * D + bj * 128;
                    const f32x4 r0 = *(const f32x4*)(R + p), r1 = *(const f32x4*)(R + p + 4);
                    *(f32x4*)(O + p) = r0 + acc[ai][bj][m][0] * scale; *(f32x4*)(O + p + 4) = r1 + acc[ai][bj][m][1] * scale;
                }
    }
};
struct EpiBf16 {
    static constexpr bool PERM = true, MIDK = false;
    bf16_t* O; int ldc; float scale;
    __device__ __forceinline__ void operator()(Acc& acc, const Unit& u, int wr, int wc, int fr, int fq) const {
        bf16_t* base = O + u.ooff + (size_t)(wr * 64 + fr) * ldc + wc * 32 + 8 * fq;
#pragma unroll
        for (int ai = 0; ai < 2; ++ai)
#pragma unroll
            for (int m = 0; m < 4; ++m)
#pragma unroll
                for (int bj = 0; bj < 2; ++bj)
                    *(u32x4*)(base + (size_t)(ai * 128 + m * 16) * ldc + bj * 128) = pack8(acc[ai][bj][m][0] * scale, acc[ai][bj][m][1] * scale);
    }
};
struct EpiWin {
    static constexpr bool PERM = true, MIDK = false;
    bf16_t *QS, *KK, *VV, *GS, *XB, *GB; float* LF; const float* LB;
    __device__ __forceinline__ void operator()(Acc& acc, const Unit& u, int wr, int wc, int fr, int fq) const {
        const int seg = u.pn >> 2;
        const int col0 = (u.pn & 3) * 256 + wc * 32 + 8 * fq;
        const size_t row0 = (size_t)u.pm * 256 + wr * 64 + fr;
        bf16_t* dst = seg == 0 ? QS : seg == 1 ? KK : seg == 2 ? VV : seg == 3 ? GS : seg == 4 ? XB : GB;
#pragma unroll
        for (int bj = 0; bj < 2; ++bj) {
            const int col = col0 + bj * 128;
            f32x4 lb0 = (f32x4){0.f, 0.f, 0.f, 0.f}, lb1 = lb0;
            if (seg == 1) { lb0 = *(const f32x4*)(LB + col); lb1 = *(const f32x4*)(LB + col + 4); }
#pragma unroll
            for (int ai = 0; ai < 2; ++ai)
#pragma unroll
                for (int m = 0; m < 4; ++m) {
                    const size_t p = (row0 + ai * 128 + m * 16) * HW + col;
                    f32x4 v0 = acc[ai][bj][m][0], v1 = acc[ai][bj][m][1];
                    if (seg == 0 || seg == 3) {
#pragma unroll
                        for (int j = 0; j < 4; ++j) { v0[j] = siluf(v0[j]); v1[j] = siluf(v1[j]); }
                    } else if (seg == 1) {
                        f32x4 l0, l1;
#pragma unroll
                        for (int j = 0; j < 4; ++j) {
                            const float s0 = sigm(v0[j]), s1 = sigm(v1[j]);
                            l0[j] = __logf(lb0[j] + (1.f - lb0[j]) * s0); l1[j] = __logf(lb1[j] + (1.f - lb1[j]) * s1);
                            v0[j] = (1.f - lb0[j]) * (1.f - s0); v1[j] = (1.f - lb1[j]) * (1.f - s1);
                        }
                        *(f32x4*)(LF + p) = l0; *(f32x4*)(LF + p + 4) = l1;
                    } else if (seg == 5) {
#pragma unroll
                        for (int j = 0; j < 4; ++j) { v0[j] = gelu_tanh(v0[j]); v1[j] = gelu_tanh(v1[j]); }
                    }
                    *(u32x4*)(dst + p) = pack8(v0, v1);
                }
        }
    }
};
struct EpiGates {
    static constexpr bool PERM = true, MIDK = false;
    bf16_t* GAB; const float* bg;
    __device__ __forceinline__ void operator()(Acc& acc, const Unit& u, int wr, int wc, int fr, int fq) const {
        const int col0 = u.pn * 256 + wc * 32 + 8 * fq;
        const size_t row0 = (size_t)u.pm * 256 + wr * 64 + fr;
#pragma unroll
        for (int bj = 0; bj < 2; ++bj) {
            const int col = col0 + bj * 128;
            const f32x4 b0 = *(const f32x4*)(bg + col), b1 = *(const f32x4*)(bg + col + 4);
#pragma unroll
            for (int ai = 0; ai < 2; ++ai)
#pragma unroll
                for (int m = 0; m < 4; ++m) {
                    f32x4 v0 = acc[ai][bj][m][0] + b0, v1 = acc[ai][bj][m][1] + b1;
#pragma unroll
                    for (int j = 0; j < 4; ++j) { v0[j] = sigm(v0[j]); v1[j] = sigm(v1[j]); }
                    *(u32x4*)(GAB + (row0 + ai * 128 + m * 16) * 4096 + col) = pack8(v0, v1);
                }
        }
    }
};
template <int PASS> struct EpiMerge {
    static constexpr bool PERM = true, MIDK = false;
    const bf16_t* GAB; bf16_t* MG;
    __device__ __forceinline__ void operator()(Acc& acc, const Unit& u, int wr, int wc, int fr, int fq) const {
        const int col0 = u.pn * 256 + wc * 32 + 8 * fq;
        const size_t row0 = (size_t)u.pm * 256 + wr * 64 + fr;
#pragma unroll
        for (int ai = 0; ai < 2; ++ai)
#pragma unroll
            for (int m = 0; m < 4; ++m)
#pragma unroll
                for (int bj = 0; bj < 2; ++bj) {
                    const size_t r = row0 + ai * 128 + m * 16; const int col = col0 + bj * 128;
                    const u32x4 b = *(const u32x4*)(GAB + r * 4096 + PASS * 2048 + col);
                    f32x4 v0 = acc[ai][bj][m][0], v1 = acc[ai][bj][m][1];
                    v0[0] *= bflo(b.x); v0[1] *= bfhi(b.x); v0[2] *= bflo(b.y); v0[3] *= bfhi(b.y);
                    v1[0] *= bflo(b.z); v1[1] *= bfhi(b.z); v1[2] *= bflo(b.w); v1[3] *= bfhi(b.w);
                    if (PASS == 1) {
                        const u32x4 p = *(const u32x4*)(MG + r * D + col);
                        v0[0] += bflo(p.x); v0[1] += bfhi(p.x); v0[2] += bflo(p.y); v0[3] += bfhi(p.y);
                        v1[0] += bflo(p.z); v1[1] += bfhi(p.z); v1[2] += bflo(p.w); v1[3] += bfhi(p.w);
                    }
                    *(u32x4*)(MG + r * D + col) = pack8(v0, v1);
                }
    }
};
struct EpiSoftmax {
    static constexpr bool PERM = true, MIDK = false;
    bf16_t* P; LAS float* SM; LAS float* SS;
    __device__ __forceinline__ void operator()(Acc& acc, const Unit& u, int wr, int wc, int fr, int fq) const {
        float mx[2][4];
#pragma unroll
        for (int ai = 0; ai < 2; ++ai)
#pragma unroll
            for (int m = 0; m < 4; ++m) {
                float v = -3.0e38f;
#pragma unroll
                for (int bj = 0; bj < 2; ++bj)
#pragma unroll
                    for (int n = 0; n < 2; ++n)
#pragma unroll
                        for (int j = 0; j < 4; ++j) v = fmaxf(v, acc[ai][bj][m][n][j]);
                v = fmaxf(v, __shfl_xor(v, 16)); v = fmaxf(v, __shfl_xor(v, 32));
                if (fq == 0) SM[(ai * 128 + wr * 64 + m * 16 + fr) * 4 + wc] = v;
            }
        LDS_WAIT(); __builtin_amdgcn_s_barrier(); asm volatile("" ::: "memory");
#pragma unroll
        for (int ai = 0; ai < 2; ++ai)
#pragma unroll
            for (int m = 0; m < 4; ++m) {
                const f32x4 q = *(const LAS f32x4*)(SM + (ai * 128 + wr * 64 + m * 16 + fr) * 4);
                const float M = fmaxf(fmaxf(q[0], q[1]), fmaxf(q[2], q[3]));
                float s = 0.f;
#pragma unroll
                for (int bj = 0; bj < 2; ++bj)
#pragma unroll
                    for (int n = 0; n < 2; ++n)
#pragma unroll
                        for (int j = 0; j < 4; ++j) { const float e = __expf(acc[ai][bj][m][n][j] - M); acc[ai][bj][m][n][j] = e; s += e; }
                s += __shfl_xor(s, 16); s += __shfl_xor(s, 32);
                if (fq == 0) SS[(ai * 128 + wr * 64 + m * 16 + fr) * 4 + wc] = s;
            }
        LDS_WAIT(); __builtin_amdgcn_s_barrier(); asm volatile("" ::: "memory");
        bf16_t* base = P + u.ooff + (size_t)(wr * 64 + fr) * 1024 + wc * 32 + 8 * fq;
#pragma unroll
        for (int ai = 0; ai < 2; ++ai)
#pragma unroll
            for (int m = 0; m < 4; ++m) {
                const f32x4 q = *(const LAS f32x4*)(SS + (ai * 128 + wr * 64 + m * 16 + fr) * 4);
                const float inv = __builtin_amdgcn_rcpf((q[0] + q[1]) + (q[2] + q[3]));
#pragma unroll
                for (int bj = 0; bj < 2; ++bj)
                    *(u32x4*)(base + (size_t)(ai * 128 + m * 16) * 1024 + bj * 128) = pack8(acc[ai][bj][m][0] * inv, acc[ai][bj][m][1] * inv);
            }
    }
};
}

struct Args {
    const float* in[29]; float* out; unsigned char* ws; int ph_lo, ph_hi;
};

__device__ __forceinline__ void transpose_item(const float* W, int N, bf16_t* WT, int dstK, size_t drow0, int kdst0, int k0, int n0, LAS float* scr, int lane) {
#pragma unroll 8
    for (int i = 0; i < 32; ++i) { const int kk = 2 * i + (lane >> 5); scr[kk * 33 + (lane & 31)] = W[(size_t)(k0 + kk) * N + n0 + (lane & 31)]; }
    LDS_WAIT();
    const int c = lane & 7;
#pragma unroll
    for (int j = 0; j < 4; ++j) { const int n = (lane >> 3) + 8 * j; const LAS float* s = scr + (8 * c) * 33 + n;
        u32x4 o; o.x = cvt_pk_bf16(s[0 * 33], s[1 * 33]); o.y = cvt_pk_bf16(s[2 * 33], s[3 * 33]); o.z = cvt_pk_bf16(s[4 * 33], s[5 * 33]); o.w = cvt_pk_bf16(s[6 * 33], s[7 * 33]);
        *(u32x4*)(WT + (drow0 + n) * dstK + kdst0 + k0 + 8 * c) = o; }
    LDS_WAIT();
}
__device__ __forceinline__ void transpose_matrix(const float* W, int K, int N, bf16_t* WT, int dstK, int kdst0, int mode, LAS float* scr, int gw, int NGW, int lane) {
    const int nblk = N / 32, items = (K / 64) * nblk;
    for (int it = gw; it < items; it += NGW) {
        const int kb = it / nblk, nb = it % nblk, n0 = nb * 32;
        size_t drow0 = (size_t)n0;
        if (mode == 1) { const int half = n0 >= DFF ? 1 : 0, nn = n0 - half * DFF; drow0 = (size_t)(nn >> 7) * 256 + half * 128 + (nn & 127); }
        transpose_item(W, N, WT, dstK, drow0, kdst0, kb * 64, n0, scr, lane);
    }
}
__device__ __forceinline__ void rms_row_bf16(const float* xrow, const float* g, bf16_t* orow, int lane) {
    f32x4 v[8]; float s = 0.f;
#pragma unroll
    for (int j = 0; j < 8; ++j) { v[j] = __builtin_nontemporal_load((const f32x4*)xrow + lane + 64 * j); s += (v[j][0] * v[j][0] + v[j][1] * v[j][1]) + (v[j][2] * v[j][2] + v[j][3] * v[j][3]); }
    const float rstd = rsqrtf(wave_sum(s) * (1.f / D) + EPS);
#pragma unroll
    for (int j = 0; j < 8; ++j) { const f32x4 gg = ((const f32x4*)g)[lane + 64 * j]; u32x2 o; o.x = cvt_pk_bf16(v[j][0] * rstd * gg[0], v[j][1] * rstd * gg[1]); o.y = cvt_pk_bf16(v[j][2] * rstd * gg[2], v[j][3] * rstd * gg[3]);
        __builtin_nontemporal_store(o, (u32x2*)orow + lane + 64 * j); }
}
__device__ __forceinline__ void rms_row2_bf16(const float* xa, const float* xb, const float* g, bf16_t* oa, bf16_t* ob, int lane) {
    f32x4 va[8], vb[8]; float sa = 0.f, sb = 0.f;
#pragma unroll
    for (int j = 0; j < 8; ++j) { va[j] = __builtin_nontemporal_load((const f32x4*)xa + lane + 64 * j); vb[j] = __builtin_nontemporal_load((const f32x4*)xb + lane + 64 * j); }
#pragma unroll
    for (int j = 0; j < 8; ++j) { sa += (va[j][0] * va[j][0] + va[j][1] * va[j][1]) + (va[j][2] * va[j][2] + va[j][3] * va[j][3]); sb += (vb[j][0] * vb[j][0] + vb[j][1] * vb[j][1]) + (vb[j][2] * vb[j][2] + vb[j][3] * vb[j][3]); }
    const float ra = rsqrtf(wave_sum(sa) * (1.f / D) + EPS), rb = rsqrtf(wave_sum(sb) * (1.f / D) + EPS);
#pragma unroll
    for (int j = 0; j < 8; ++j) { const f32x4 gg = ((const f32x4*)g)[lane + 64 * j]; u32x2 o;
        o.x = cvt_pk_bf16(va[j][0] * ra * gg[0], va[j][1] * ra * gg[1]); o.y = cvt_pk_bf16(va[j][2] * ra * gg[2], va[j][3] * ra * gg[3]); __builtin_nontemporal_store(o, (u32x2*)oa + lane + 64 * j);
        o.x = cvt_pk_bf16(vb[j][0] * rb * gg[0], vb[j][1] * rb * gg[1]); o.y = cvt_pk_bf16(vb[j][2] * rb * gg[2], vb[j][3] * rb * gg[3]); __builtin_nontemporal_store(o, (u32x2*)ob + lane + 64 * j); }
}
__device__ __forceinline__ void norm_all_bf16(const float* src, const float* g, bf16_t* dst, int gw, int NGW, int lane) {
    int m = gw;
    for (; m + NGW < T; m += 2 * NGW) rms_row2_bf16(src + (size_t)m * D, src + (size_t)(m + NGW) * D, g, dst + (size_t)m * D, dst + (size_t)(m + NGW) * D, lane);
    for (; m < T; m += NGW) rms_row_bf16(src + (size_t)m * D, g, dst + (size_t)m * D, lane);
}
__device__ __forceinline__ void rms_row_f32(float* xrow, const float* g, int lane) {
    f32x4 v[8]; float s = 0.f;
#pragma unroll
    for (int j = 0; j < 8; ++j) { v[j] = __builtin_nontemporal_load((const f32x4*)xrow + lane + 64 * j); s += (v[j][0] * v[j][0] + v[j][1] * v[j][1]) + (v[j][2] * v[j][2] + v[j][3] * v[j][3]); }
    const float rstd = rsqrtf(wave_sum(s) * (1.f / D) + EPS);
#pragma unroll
    for (int j = 0; j < 8; ++j) { const f32x4 gg = ((const f32x4*)g)[lane + 64 * j]; __builtin_nontemporal_store(v[j] * rstd * gg, (f32x4*)xrow + lane + 64 * j); }
}

#define MFMA16(a, b, c) __builtin_amdgcn_mfma_f32_16x16x32_bf16((a), (b), (c), 0, 0, 0)
__device__ __forceinline__ void hgrn_item(LAS unsigned char* lds, int item, const bf16_t* QS, const float* LF, const bf16_t* KK, const bf16_t* VV, bf16_t* YAB) {
    const int tid = threadIdx.x, lane = tid & 63, wid = tid >> 6, l15 = lane & 15, quad = lane >> 4;
    const int b = item >> 4, h = (item >> 1) & 7, vh = item & 1;
    LAS bf16_t* QT = (LAS bf16_t*)(lds + 0);
    LAS bf16_t* KT = (LAS bf16_t*)(lds + 17408);
    LAS bf16_t* QH = (LAS bf16_t*)(lds + 34816);
    LAS bf16_t* KD = (LAS bf16_t*)(lds + 52224);
    LAS bf16_t* VT = (LAS bf16_t*)(lds + 70656);
    LAS bf16_t* PP = (LAS bf16_t*)(lds + 79872);
    LAS bf16_t* ST = (LAS bf16_t*)(lds + 89088);
    LAS float* DD = (LAS float*)(lds + 106496);
    LAS float* PS = (LAS float*)(lds + 107008);
    const int k = tid & 127, part = tid >> 7;
    const int vv = tid & 63, sg = tid >> 6;
    const size_t row0 = (size_t)b * SEQ;
    const int colq = h * 128 + k, colv = h * 128 + vh * 64 + vv;
    const int tt = wid >> 1, vt0 = (wid & 1) * 2;
    f32x4 S[4];
#pragma unroll
    for (int i = 0; i < 4; ++i) S[i] = (f32x4){0.f, 0.f, 0.f, 0.f};
    for (int i = tid; i < 64 * 136 / 2; i += NTHREADS) ((LAS unsigned*)ST)[i] = 0u;
    float lfv[16]; bf16_t qv[16], kv[16], vr[8];
#define HG_LOAD(c) do { const size_t r_ = row0 + (size_t)(c) * 64; \
        _Pragma("unroll") for (int i = 0; i < 16; ++i) { const size_t p_ = (r_ + part * 16 + i) * HW + colq; lfv[i] = LF[p_]; qv[i] = QS[p_]; kv[i] = KK[p_]; } \
        _Pragma("unroll") for (int i = 0; i < 8; ++i) vr[i] = VV[(r_ + sg * 8 + i) * HW + colv]; } while (0)
    HG_LOAD(0);
    for (int c = 0; c < 64; ++c) {
        float bl[16]; float run = 0.f;
#pragma unroll
        for (int i = 0; i < 16; ++i) { run += lfv[i]; bl[i] = run; }
        PS[part * 128 + k] = run;
        __syncthreads();
        const float p0 = PS[k], p1 = PS[128 + k], p2 = PS[256 + k], p3 = PS[384 + k];
        const float pre = part == 0 ? 0.f : part == 1 ? p0 : part == 2 ? p0 + p1 : p0 + p1 + p2;
        const float mref = p0 + p1, blast = (p0 + p1) + (p2 + p3);
        const float em = __expf(mref), ebm = __expf(blast - mref);
        float kd[16];
#pragma unroll
        for (int i = 0; i < 16; ++i) {
            const float bb = pre + bl[i];
            const float e1 = __expf(fminf(fmaxf(bb - mref, -80.f), 80.f)), e2 = __builtin_amdgcn_rcpf(e1);
            const float q = bf2f(qv[i]), kx = bf2f(kv[i]);
            const int s = part * 16 + i;
            QT[s * 136 + k] = f2bf(q * e1); KT[s * 136 + k] = f2bf(kx * e2); QH[s * 136 + k] = f2bf(q * e1 * em); kd[i] = kx * e2 * ebm;
        }
        { u32x4 w0, w1;
          w0.x = cvt_pk_bf16(kd[0], kd[1]); w0.y = cvt_pk_bf16(kd[2], kd[3]); w0.z = cvt_pk_bf16(kd[4], kd[5]); w0.w = cvt_pk_bf16(kd[6], kd[7]);
          w1.x = cvt_pk_bf16(kd[8], kd[9]); w1.y = cvt_pk_bf16(kd[10], kd[11]); w1.z = cvt_pk_bf16(kd[12], kd[13]); w1.w = cvt_pk_bf16(kd[14], kd[15]);
          *(LAS u32x4*)(KD + k * 72 + part * 16) = w0; *(LAS u32x4*)(KD + k * 72 + part * 16 + 8) = w1; }
        if (part == 0) DD[k] = em * ebm;
        { u32x4 w; w.x = (unsigned)vr[0] | ((unsigned)vr[1] << 16); w.y = (unsigned)vr[2] | ((unsigned)vr[3] << 16); w.z = (unsigned)vr[4] | ((unsigned)vr[5] << 16); w.w = (unsigned)vr[6] | ((unsigned)vr[7] << 16);
          *(LAS u32x4*)(VT + vv * 72 + sg * 8) = w; }
        __syncthreads();
        if (c + 1 < 64) HG_LOAD(c + 1);
        f32x4 acc_o[2];
        acc_o[0] = (f32x4){0.f, 0.f, 0.f, 0.f}; acc_o[1] = acc_o[0];
        {
            const int ti = wid >> 1;
#pragma unroll
            for (int q2 = 0; q2 < 2; ++q2) {
                const int si = (wid & 1) * 2 + q2;
                f32x4 a = (f32x4){0.f, 0.f, 0.f, 0.f};
                if (si <= ti) {
#pragma unroll
                    for (int ks = 0; ks < 4; ++ks) {
                        const bf16x8 af = *(const LAS bf16x8*)(QT + (ti * 16 + l15) * 136 + ks * 32 + quad * 8);
                        const bf16x8 bfr = *(const LAS bf16x8*)(KT + (si * 16 + l15) * 136 + ks * 32 + quad * 8);
                        a = MFMA16(af, bfr, a);
                    }
                }
#pragma unroll
                for (int j = 0; j < 4; ++j) { const int t = ti * 16 + quad * 4 + j, s = si * 16 + l15; PP[t * 72 + s] = f2bf((s <= t) ? a[j] : 0.f); }
            }
#pragma unroll
            for (int ks = 0; ks < 4; ++ks) {
                const bf16x8 af = *(const LAS bf16x8*)(QH + (tt * 16 + l15) * 136 + ks * 32 + quad * 8);
#pragma unroll
                for (int v2 = 0; v2 < 2; ++v2) {
                    const bf16x8 bfr = *(const LAS bf16x8*)(ST + ((vt0 + v2) * 16 + l15) * 136 + ks * 32 + quad * 8);
                    acc_o[v2] = MFMA16(af, bfr, acc_o[v2]);
                }
            }
        }
        __syncthreads();
#pragma unroll
        for (int ks = 0; ks < 2; ++ks) {
            const bf16x8 af = *(const LAS bf16x8*)(PP + (tt * 16 + l15) * 72 + ks * 32 + quad * 8);
#pragma unroll
            for (int v2 = 0; v2 < 2; ++v2) {
                const bf16x8 bfr = *(const LAS bf16x8*)(VT + ((vt0 + v2) * 16 + l15) * 72 + ks * 32 + quad * 8);
                acc_o[v2] = MFMA16(af, bfr, acc_o[v2]);
            }
        }
#pragma unroll
        for (int v2 = 0; v2 < 2; ++v2)
#pragma unroll
            for (int j = 0; j < 4; ++j) YAB[(row0 + (size_t)c * 64 + tt * 16 + quad * 4 + j) * D + h * 128 + vh * 64 + (vt0 + v2) * 16 + l15] = f2bf(acc_o[v2][j]);
        {
            const f32x4 dv = *(const LAS f32x4*)(DD + wid * 16 + quad * 4);
#pragma unroll
            for (int v4 = 0; v4 < 4; ++v4) S[v4] *= dv;
#pragma unroll
            for (int ks = 0; ks < 2; ++ks) {
                const bf16x8 af = *(const LAS bf16x8*)(KD + (wid * 16 + l15) * 72 + ks * 32 + quad * 8);
#pragma unroll
                for (int v4 = 0; v4 < 4; ++v4) {
                    const bf16x8 bfr = *(const LAS bf16x8*)(VT + (v4 * 16 + l15) * 72 + ks * 32 + quad * 8);
                    S[v4] = MFMA16(af, bfr, S[v4]);
                }
            }
#pragma unroll
            for (int v4 = 0; v4 < 4; ++v4) { u32x2 w; w.x = cvt_pk_bf16(S[v4][0], S[v4][1]); w.y = cvt_pk_bf16(S[v4][2], S[v4][3]); *(LAS u32x2*)(ST + (v4 * 16 + l15) * 136 + wid * 16 + quad * 4) = w; }
        }
    }
#undef HG_LOAD
    __syncthreads();
}

__device__ __forceinline__ void lru_item(LAS unsigned char* lds, int item, const bf16_t* XB, const bf16_t* GB, const float* conv_w, const float* conv_b, const bf16_t* WLA, const bf16_t* WLX,
                                         const float* ba, const float* bx, const float* lam, bf16_t* YAB) {
    const int tid = threadIdx.x, lane = tid & 63, wid = tid >> 6, l15 = lane & 15, quad = lane >> 4;
    const int b = item >> 4, n = (item >> 1) & 7, oh = item & 1;
    LAS bf16_t* XC = (LAS bf16_t*)(lds + 0);
    LAS bf16_t* WL = (LAS bf16_t*)(lds + 17408);
    LAS float* XCF = (LAS float*)(lds + 52224);
    LAS float* AA = XCF + 64 * 65;
    LAS float* UU = AA + 64 * 65;
    LAS float* GA = UU + 64 * 65;
    LAS float* GH = GA + 512;
    LAS float* HC = GH + 512;
    const int ch = tid & 127, part = tid >> 7;
    const int st = wid >> 1, ct0 = (wid & 1) * 2;
    const int cl = tid & 63, g = tid >> 6;
    const size_t row0 = (size_t)b * SEQ;
    const int colc = n * 128 + ch;
    const float w0 = conv_w[0 * HW + colc], w1 = conv_w[1 * HW + colc], w2 = conv_w[2 * HW + colc], w3 = conv_w[3 * HW + colc], cb = conv_b[colc];
    const bool own = (ch >> 6) == oh;
    for (int i = tid; i < 2048; i += NTHREADS) {
        const int mat = i >> 10, r = (i >> 4) & 63, kc = i & 15;
        const bf16_t* src = (mat ? WLX : WLA) + (size_t)(n * 128 + oh * 64 + r) * 128 + kc * 8;
        *(LAS u32x4*)(WL + (mat * 64 + r) * 136 + kc * 8) = *(const u32x4*)src;
    }
    float bav[2], bxv[2], lsl[2];
#pragma unroll
    for (int c2 = 0; c2 < 2; ++c2) { const int cp = n * 128 + oh * 64 + (ct0 + c2) * 16 + l15; bav[c2] = ba[cp]; bxv[c2] = bx[cp]; lsl[c2] = -log1pf(__expf(-lam[cp])); }
    const int colo = n * 128 + oh * 64 + cl;
    if (tid < 64) HC[tid] = 0.f;
    for (int c = 0; c < 64; ++c) {
        float xin[19];
        { const int t0 = c * 64 + part * 16;
#pragma unroll
          for (int i = 0; i < 19; ++i) { const int t = t0 - 3 + i; xin[i] = (t >= 0) ? bf2f(XB[(row0 + t) * HW + colc]) : 0.f; } }
        float gbv[8];
#pragma unroll
        for (int i = 0; i < 8; ++i) gbv[i] = bf2f(GB[(row0 + (size_t)c * 64 + g * 8 + i) * HW + colo]);
#pragma unroll
        for (int i = 0; i < 16; ++i) {
            const float xc = cb + w0 * xin[i + 3] + w1 * xin[i + 2] + w2 * xin[i + 1] + w3 * xin[i];
            XC[(part * 16 + i) * 136 + ch] = f2bf(xc);
            if (own) XCF[(part * 16 + i) * 65 + (ch & 63)] = xc;
        }
        __syncthreads();
        {
            f32x4 ar[2], ai[2];
            ar[0] = (f32x4){0.f, 0.f, 0.f, 0.f}; ar[1] = ar[0]; ai[0] = ar[0]; ai[1] = ar[0];
#pragma unroll
            for (int ks = 0; ks < 4; ++ks) {
                const bf16x8 af = *(const LAS bf16x8*)(XC + (st * 16 + l15) * 136 + ks * 32 + quad * 8);
#pragma unroll
                for (int c2 = 0; c2 < 2; ++c2) {
                    const bf16x8 fa = *(const LAS bf16x8*)(WL + ((ct0 + c2) * 16 + l15) * 136 + ks * 32 + quad * 8);
                    const bf16x8 fx = *(const LAS bf16x8*)(WL + (64 + (ct0 + c2) * 16 + l15) * 136 + ks * 32 + quad * 8);
                    ar[c2] = MFMA16(af, fa, ar[c2]); ai[c2] = MFMA16(af, fx, ai[c2]);
                }
            }
#pragma unroll
            for (int c2 = 0; c2 < 2; ++c2)
#pragma unroll
                for (int j = 0; j < 4; ++j) {
                    const int s = st * 16 + quad * 4 + j, cc = (ct0 + c2) * 16 + l15;
                    const float r = sigm(ar[c2][j] + bav[c2]), ig = sigm(ai[c2][j] + bxv[c2]);
                    const float la = 8.f * r * lsl[c2];
                    const float a = __expf(la);
                    float mult = sqrtf(fmaxf(-expm1f(2.f * la), 0.f));
                    if (c == 0 && s == 0) mult = 1.f;
                    AA[s * 65 + cc] = a; UU[s * 65 + cc] = XCF[s * 65 + cc] * ig * mult;
                }
        }
        __syncthreads();
        float a8[8], u8[8];
#pragma unroll
        for (int i = 0; i < 8; ++i) { a8[i] = AA[(g * 8 + i) * 65 + cl]; u8[i] = UU[(g * 8 + i) * 65 + cl]; }
        { float pa = 1.f, ph = 0.f;
#pragma unroll
          for (int i = 0; i < 8; ++i) { pa *= a8[i]; ph = a8[i] * ph + u8[i]; }
          GA[g * 64 + cl] = pa; GH[g * 64 + cl] = ph; }
        __syncthreads();
        float hh = HC[(c & 1) * 64 + cl];
        for (int g2 = 0; g2 < g; ++g2) hh = GA[g2 * 64 + cl] * hh + GH[g2 * 64 + cl];
#pragma unroll
        for (int i = 0; i < 8; ++i) { hh = a8[i] * hh + u8[i]; YAB[(row0 + (size_t)c * 64 + g * 8 + i) * D + HW + colo] = f2bf(DBG_YB_SCALE * hh * gbv[i]); }
        if (g == 7) HC[((c + 1) & 1) * 64 + cl] = hh;
    }
    __syncthreads();
}

#define XB_TMO      128
#define XB_XCNT(j)  (256  + 64 * (j))
#define XB_XSUB(j)  (1280 + 64 * (j))
#define XB_XGEN(j)  (2304 + 64 * (j))
#define XB_TOP      3328
#define XB_TOPGEN   3392
#define XCD_BAR_WORDS 3456
#define XB_SPIN_CAP (1u << 18)

__device__ __forceinline__ unsigned xb_ld(unsigned* p)              { return __hip_atomic_load(p, __ATOMIC_RELAXED, __HIP_MEMORY_SCOPE_AGENT); }
__device__ __forceinline__ unsigned xb_add(unsigned* p, unsigned v) { return __hip_atomic_fetch_add(p, v, __ATOMIC_RELAXED, __HIP_MEMORY_SCOPE_AGENT); }
__device__ __forceinline__ unsigned xb_xcc_id() { return (unsigned)__builtin_amdgcn_s_getreg((3 << 11) | 20) & 0xFu; }
#define XB_SPIN(cond, bar) do { unsigned _sp = 0; while (cond) { __builtin_amdgcn_s_sleep(1); \
    if ((++_sp & 255u) == 0u) { if (xb_ld(&(bar)[XB_TMO])) break; if (_sp > XB_SPIN_CAP) { atomicAdd(&(bar)[XB_TMO], 1u); break; } } } } while (0)

struct XcdBarrier {
    unsigned* bar; unsigned x;
    volatile LAS unsigned* st;
};

__device__ __forceinline__ XcdBarrier xcd_barrier_post(unsigned* bar, volatile LAS unsigned* st) {
    XcdBarrier b; b.bar = bar; b.x = xb_xcc_id(); b.st = st;
    if (threadIdx.x == 0) (void)xb_add(&bar[XB_XCNT(b.x)], 1u);
    return b;
}
__device__ __forceinline__ void xcd_barrier_complete(unsigned* bar, unsigned x, unsigned& nloc, unsigned& nx) {
    const unsigned G = gridDim.x * gridDim.y * gridDim.z;
    unsigned sum, cnt, mine, sp = 0u;
    for (;;) {
        sum = 0u; cnt = 0u; mine = 0u;
#pragma unroll
        for (unsigned j = 0; j < 16; ++j) { const unsigned c = xb_ld(&bar[XB_XCNT(j)]); sum += c; cnt += (c > 0u) ? 1u : 0u; mine = (j == x) ? c : mine; }
        if (sum == G) break;
        __builtin_amdgcn_s_sleep(1);
        if ((++sp & 255u) == 0u) { if (xb_ld(&bar[XB_TMO])) break; if (sp > XB_SPIN_CAP) { atomicAdd(&bar[XB_TMO], 1u); break; } }
    }
    nloc = mine > 0u ? mine : 1u; nx = cnt > 0u ? cnt : 1u;
}

__device__ __forceinline__ void xcd_barrier(const XcdBarrier& b) {
    asm volatile("s_waitcnt vmcnt(0)" ::: "memory");
    __syncthreads();
    if (threadIdx.x == 0) {
        unsigned* bar = b.bar;
        __builtin_amdgcn_s_waitcnt(0);
        unsigned nloc = b.st[0], nx = b.st[1];
        if (nloc == 0u) { xcd_barrier_complete(bar, b.x, nloc, nx); b.st[0] = nloc; b.st[1] = nx; }
        const unsigned old = xb_add(&bar[XB_XSUB(b.x)], 1u);
        const unsigned gen = old / nloc;
        if (old + 1u == (gen + 1u) * nloc) {
            __builtin_amdgcn_fence(__ATOMIC_RELEASE, "agent");
            asm volatile("s_waitcnt vmcnt(0)" ::: "memory");
            const unsigned og = xb_add(&bar[XB_TOP], 1u);
            const unsigned tg = og / nx;
            if (og + 1u == (tg + 1u) * nx) xb_add(&bar[XB_TOPGEN], 1u);
            else XB_SPIN(xb_ld(&bar[XB_TOPGEN]) == tg, bar);
            __builtin_amdgcn_fence(__ATOMIC_ACQUIRE, "agent");
            xb_add(&bar[XB_XGEN(b.x)], 1u);
            asm volatile("s_waitcnt vmcnt(0)" ::: "memory");
        } else {
            XB_SPIN(xb_ld(&bar[XB_XGEN(b.x)]) == gen, bar);
            __builtin_amdgcn_fence(__ATOMIC_ACQUIRE, "agent");
            asm volatile("s_waitcnt vmcnt(0)" ::: "memory");
        }
    }
    __syncthreads();
}

__global__ void __launch_bounds__(NTHREADS, 2) fwd_kernel(Args args) {
    extern __shared__ __attribute__((aligned(16))) unsigned char lds_raw[];
    LAS unsigned char* lds = (LAS unsigned char*)lds_raw;
    cg::grid_group grid = cg::this_grid();
    const int tid = threadIdx.x, lane = tid & 63, wave = __builtin_amdgcn_readfirstlane(tid >> 6);
    const int G = gridDim.x, bid = blockIdx.x;
    const int gw = bid * 8 + wave, NGW = G * 8;
    unsigned char* ws = args.ws;
    const float* x = args.in[0]; const float* mem = args.in[1];
    const float* ffn1_norm = args.in[2]; const float* ffn1_w_up = args.in[3]; const float* ffn1_w_down = args.in[4];
    const float* mix_norm = args.in[5]; const float* w_in = args.in[6]; const float* b_gate = args.in[7];
    const float* lb_logits = args.in[8]; const float* hgrn_norm = args.in[9];
    const float* conv_w = args.in[10]; const float* conv_b = args.in[11];
    const float* lru_wa = args.in[12]; const float* lru_ba = args.in[13]; const float* lru_wx = args.in[14]; const float* lru_bx = args.in[15]; const float* lru_lambda = args.in[16];
    const float* w_branch_a = args.in[17]; const float* w_branch_b = args.in[18]; const float* w_out = args.in[19];
    const float* xattn_norm = args.in[20]; const float* mem_norm = args.in[21]; const float* xattn_wq = args.in[22]; const float* xattn_wkv = args.in[23]; const float* xattn_wo = args.in[24];
    const float* ffn2_norm = args.in[25]; const float* ffn2_w_up = args.in[26]; const float* ffn2_w_down = args.in[27]; const float* final_norm = args.in[28];
    float* out = args.out;
    bf16_t* Wb = (bf16_t*)(ws + WS_W);
    bf16_t *WUP1 = Wb + E_WUP1, *WDN1 = Wb + E_WDN1, *WIN = Wb + E_WIN, *WAB = Wb + E_WAB, *WOUT = Wb + E_WOUT, *WQ = Wb + E_WQ, *WKV = Wb + E_WKV, *WO = Wb + E_WO,
           *WUP2 = Wb + E_WUP2, *WDN2 = Wb + E_WDN2, *WLA = Wb + E_WLA, *WLX = Wb + E_WLX;
    float* LB = (float*)(ws + WS_CTL);
    bf16_t* XN = (bf16_t*)(ws + WS_XN); bf16_t* YAB = (bf16_t*)(ws + WS_YAB); bf16_t* HB = (bf16_t*)(ws + WS_HB);
    bf16_t *QS = (bf16_t*)(ws + WS_QS), *KK = (bf16_t*)(ws + WS_KK), *VV = (bf16_t*)(ws + WS_VV), *GS = (bf16_t*)(ws + WS_GS), *XB = (bf16_t*)(ws + WS_XB), *GB = (bf16_t*)(ws + WS_GB);
    float* LF = (float*)(ws + WS_LF);
    bf16_t *GAB = (bf16_t*)(ws + WS_GAB), *MG = (bf16_t*)(ws + WS_MG), *Qb = (bf16_t*)(ws + WS_Q), *Pb = (bf16_t*)(ws + WS_P), *Ob = (bf16_t*)(ws + WS_O);
    bf16_t *KMAT = (bf16_t*)(ws + WS_KMAT), *VT = (bf16_t*)(ws + WS_VT), *MEMN = (bf16_t*)(ws + WS_MEMN);
    bf16_t *MTb = YAB, *NTb = YAB + (size_t)32 * 256 * D;

    const int lo = args.ph_lo, hi = args.ph_hi;
#ifndef DUP_MASK
#define DUP_MASK 0
#endif
#ifndef PH_MASK
#define PH_MASK 0x3ffff
#endif
#define IN(k) (((PH_MASK >> (k)) & 1) && lo <= (k) && (k) < hi)
#define SEAM(k) do { if (lo <= (k) && (k) + 1 < hi) { if ((k) == 0) { asm volatile("s_waitcnt vmcnt(0) lgkmcnt(0)" ::: "memory"); __syncthreads(); grid.sync(); \
        if (tid == 0) { __builtin_amdgcn_fence(__ATOMIC_ACQUIRE, "agent"); asm volatile("s_waitcnt vmcnt(0)" ::: "memory"); } __syncthreads(); } else { xcd_barrier(xbar); } } } while (0)
    volatile LAS unsigned* MISC = (volatile LAS unsigned*)(lds + STAGE_BYTES + 12288);
    if (tid < 4) MISC[tid] = 0u;
    __syncthreads();
    XcdBarrier xbar = xcd_barrier_post((unsigned*)(ws + WS_CTL + 131072), MISC);

    if (IN(0)) {
        LAS float* scr = (LAS float*)(lds + wave * 16384);
        transpose_matrix(ffn1_w_up, D, 2 * DFF, WUP1, D, 0, 1, scr, gw, NGW, lane);
        transpose_matrix(ffn1_w_down, DFF, D, WDN1, DFF, 0, 0, scr, gw, NGW, lane);
        transpose_matrix(w_in, D, 10240, WIN, D, 0, 0, scr, gw, NGW, lane);
        transpose_matrix(w_branch_a, HW, D, WAB, D, 0, 0, scr, gw, NGW, lane);
        transpose_matrix(w_branch_b, HW, D, WAB, D, HW, 0, scr, gw, NGW, lane);
        transpose_matrix(w_out, D, D, WOUT, D, 0, 0, scr, gw, NGW, lane);
        for (size_t i = ((size_t)gw * 64 + lane) * 8; i < (size_t)D * D; i += (size_t)NGW * 64 * 8)
            *(u32x4*)(WQ + i) = pg8::pack8(*(const f32x4*)(xattn_wq + i), *(const f32x4*)(xattn_wq + i + 4));
        transpose_matrix(xattn_wkv, D, 2 * D, WKV, D, 0, 0, scr, gw, NGW, lane);
        transpose_matrix(xattn_wo, D, D, WO, D, 0, 0, scr, gw, NGW, lane);
        transpose_matrix(ffn2_w_up, D, 2 * DFF, WUP2, D, 0, 1, scr, gw, NGW, lane);
        transpose_matrix(ffn2_w_down, DFF, D, WDN2, DFF, 0, 0, scr, gw, NGW, lane);
        for (int nb = 0; nb < 8; ++nb) {
            transpose_matrix(lru_wa + nb * 16384, 128, 128, WLA + nb * 16384, 128, 0, 0, scr, gw, NGW, lane);
            transpose_matrix(lru_wx + nb * 16384, 128, 128, WLX + nb * 16384, 128, 0, 0, scr, gw, NGW, lane);
        }
        norm_all_bf16(x, ffn1_norm, XN, gw, NGW, lane);
        for (int m = gw; m < NBATCH * NMEM; m += NGW) rms_row_bf16(mem + (size_t)m * D, mem_norm, MEMN + (size_t)m * D, lane);
        for (int i = bid * NTHREADS + tid; i < HW; i += G * NTHREADS) LB[i] = sigm(lb_logits[i] - lb_logits[HW + i]);
        __syncthreads();
    }
    SEAM(0);
    if (IN(1)) { pg8::StdOrder S; S.init(T, 2 * DFF, G, bid, D, D, DFF, 128); pg8::EpiSwiGLU E{HB}; pg8::gemm_phase(lds, XN, WUP1, D, D, D, S, E); }
    SEAM(1);
    if (IN(2)) { pg8::StdOrder S; S.init(T, D, G, bid, DFF, DFF, D, 256); pg8::EpiResid E{x, out, 0.5f}; pg8::gemm_phase(lds, HB, WDN1, DFF, DFF, DFF, S, E); }
    SEAM(2);
    if (IN(3)) {
        { pg8::StdOrder S; S.init(NBATCH * NMEM, D, G, bid, D, D, D, 256); pg8::EpiBf16 E{KMAT, D, 1.f}; pg8::gemm_phase(lds, MEMN, WKV, D, D, D, S, E); }
        { pg8::StdOrder S; S.init(NBATCH * NMEM, D, G, (bid + 64) % G, D, D, D, 256); pg8::EpiBf16 E{VT, D, 1.f}; pg8::gemm_phase(lds, MEMN, WKV + (size_t)D * D, D, D, D, S, E); }
        if (G == 256) {
            const bool gb = (bid < 64) || (bid >= 192);
            const int cb = gb ? (bid < 64 ? bid : bid - 128) : bid - 64, wv = cb * 8 + wave;
            const int base = gb ? 20480 : 0, npair = gb ? 6 : 10;
            for (int j = 0; j < npair; ++j) { const size_t r0 = (size_t)base + wv + (size_t)(2 * j) * 1024, r1 = r0 + 1024;
                rms_row2_bf16(out + r0 * D, out + r1 * D, mix_norm, XN + r0 * D, XN + r1 * D, lane); }
        } else norm_all_bf16(out, mix_norm, XN, gw, NGW, lane);
    }
    SEAM(3);
    if (IN(4)) { pg8::StdOrder S; S.init(T, 6144, G, bid, D, D, HW, 256); pg8::EpiWin E{QS, KK, VV, GS, XB, GB, LF, LB}; pg8::gemm_phase(lds, XN, WIN, D, D, D, S, E); }
    SEAM(4);
    for (int rep_ = 0; rep_ < (((DUP_MASK >> 5) & 1) ? 2 : 1); ++rep_)
    if (IN(5)) {
        for (int it = bid; it < 256; it += G) {
            if (it < 128) hgrn_item(lds, it, QS, LF, KK, VV, YAB);
            else lru_item(lds, it - 128, XB, GB, conv_w, conv_b, WLA, WLX, lru_ba, lru_bx, lru_lambda, YAB);
        }
    }
    SEAM(5);
    if (IN(6)) {
        for (int m = gw; m < T; m += NGW) {
            bf16_t* orow = YAB + (size_t)m * D + lane * 16;
            const u32x4 a = *(const u32x4*)orow, b2 = *(const u32x4*)(orow + 8);
            float v[16] = {bflo(a.x), bfhi(a.x), bflo(a.y), bfhi(a.y), bflo(a.z), bfhi(a.z), bflo(a.w), bfhi(a.w), bflo(b2.x), bfhi(b2.x), bflo(b2.y), bfhi(b2.y), bflo(b2.z), bfhi(b2.z), bflo(b2.w), bfhi(b2.w)};
            float s = 0.f;
#pragma unroll
            for (int i = 0; i < 16; ++i) s += v[i] * v[i];
            s += __shfl_xor(s, 1); s += __shfl_xor(s, 2); s += __shfl_xor(s, 4);
            const float rstd = rsqrtf(s * (1.f / 128.f) + EPS);
            const bf16_t* grow = GS + (size_t)m * HW + lane * 16;
            const u32x4 ga = *(const u32x4*)grow, gb2 = *(const u32x4*)(grow + 8);
            const float gsv[16] = {bflo(ga.x), bfhi(ga.x), bflo(ga.y), bfhi(ga.y), bflo(ga.z), bfhi(ga.z), bflo(ga.w), bfhi(ga.w), bflo(gb2.x), bfhi(gb2.x), bflo(gb2.y), bfhi(gb2.y), bflo(gb2.z), bfhi(gb2.z), bflo(gb2.w), bfhi(gb2.w)};
            const float* hn = hgrn_norm + lane * 16;
#pragma unroll
            for (int i = 0; i < 16; ++i) v[i] = v[i] * rstd * hn[i] * gsv[i];
            u32x4 o0, o1;
            o0.x = cvt_pk_bf16(v[0], v[1]); o0.y = cvt_pk_bf16(v[2], v[3]); o0.z = cvt_pk_bf16(v[4], v[5]); o0.w = cvt_pk_bf16(v[6], v[7]);
            o1.x = cvt_pk_bf16(v[8], v[9]); o1.y = cvt_pk_bf16(v[10], v[11]); o1.z = cvt_pk_bf16(v[12], v[13]); o1.w = cvt_pk_bf16(v[14], v[15]);
            *(u32x4*)orow = o0; *(u32x4*)(orow + 8) = o1;
        }
        __syncthreads();
        { pg8::StdOrder S; S.init(T, 4096, G, bid, D, D, 4096, 256); pg8::EpiGates E{GAB, b_gate}; pg8::gemm_phase(lds, XN, WIN + (size_t)6144 * D, D, D, D, S, E); }
    }
    SEAM(6);
    if (IN(7)) {
        pg8::StdOrder S; S.init(T, D, G, bid, D, D, D, 256);
        { pg8::EpiMerge<0> E{GAB, MG}; pg8::gemm_phase(lds, YAB, WAB, HW, D, D, S, E); }
        { pg8::EpiMerge<1> E{GAB, MG}; pg8::gemm_phase(lds, YAB + HW, WAB + HW, HW, D, D, S, E); }
    }
    SEAM(7);
    if (IN(8)) { pg8::StdOrder S; S.init(T, D, G, bid, D, D, D, 256); pg8::EpiResid E{out, out, 1.f}; pg8::gemm_phase(lds, MG, WOUT, D, D, D, S, E); }
    SEAM(8);
    if (IN(9)) {
        { pg8::MtOrder S{G, bid}; pg8::EpiBf16 E{MTb, D, 0.044194173824159216f}; pg8::gemm_phase<pg8::EpiBf16, pg8::MtOrder, false, false>(lds, KMAT, WQ, XD, D, D, S, E); }
        { pg8::NtOrder S{G, bid}; pg8::EpiBf16 E{NTb, 1024, 1.f}; pg8::gemm_phase<pg8::EpiBf16, pg8::NtOrder, false, false>(lds, WO, VT, XD, D, D, S, E); }
        norm_all_bf16(out, xattn_norm, XN, gw, NGW, lane);
    }
    SEAM(9);
    if (IN(11)) { pg8::ScoreOrder S{G, bid}; pg8::EpiSoftmax E{Pb, (LAS float*)(lds + STAGE_BYTES), (LAS float*)(lds + STAGE_BYTES + 4096)}; pg8::gemm_phase<pg8::EpiSoftmax, pg8::ScoreOrder, false, false>(lds, XN, MTb, D, D, D, S, E); }
    SEAM(11);
    if (IN(13)) { pg8::OutOrder S; S.init(T, D, G, bid, 1024, 1024, D, 256); pg8::EpiResid E{out, out, 1.f}; pg8::gemm_phase(lds, Pb, NTb, 1024, 1024, 1024, S, E); }
    SEAM(13);
    if (IN(14)) { norm_all_bf16(out, ffn2_norm, XN, gw, NGW, lane); }
    SEAM(14);
    if (IN(15)) { pg8::StdOrder S; S.init(T, 2 * DFF, G, bid, D, D, DFF, 128); pg8::EpiSwiGLU E{HB}; pg8::gemm_phase(lds, XN, WUP2, D, D, D, S, E); }
    SEAM(15);
    if (IN(16)) { pg8::StdOrder S; S.init(T, D, G, bid, DFF, DFF, D, 256); pg8::EpiResid E{out, out, 0.5f}; pg8::gemm_phase(lds, HB, WDN2, DFF, DFF, DFF, S, E); }
    SEAM(16);
    if (IN(17)) { for (int m = gw; m < T; m += NGW) rms_row_f32(out + (size_t)m * D, final_norm, lane); }
#undef IN
#undef SEAM
}

constexpr int N_PHASES = 18;

extern "C" void kernel_launch(void* const* d_in, const int* in_sizes, int n_in, void* d_out, int out_size, void* d_ws, size_t ws_size, hipStream_t stream) {
    static int grid = 0;
    if (grid == 0) {
        if (n_in != 29 || out_size != T * D || ws_size < WS_END) { fprintf(stderr, "kernel_launch: unexpected shapes (n_in %d, out %d, ws %zu)\n", n_in, out_size, ws_size); grid = -1; return; }
        int dev = 0, cus = 0, per_cu = 0;
        (void)hipGetDevice(&dev);
        (void)hipDeviceGetAttribute(&cus, hipDeviceAttributeMultiprocessorCount, dev);
        if (hipFuncSetAttribute((const void*)fwd_kernel, hipFuncAttributeMaxDynamicSharedMemorySize, LDS_BYTES) != hipSuccess) { fprintf(stderr, "kernel_launch: hipFuncSetAttribute failed\n"); grid = -1; return; }
        if (hipOccupancyMaxActiveBlocksPerMultiprocessor(&per_cu, (const void*)fwd_kernel, NTHREADS, LDS_BYTES) != hipSuccess || per_cu < 1) { fprintf(stderr, "kernel_launch: occupancy query gave %d\n", per_cu); per_cu = 1; }
        (void)hipGetLastError();
        grid = cus * 1;
        if (grid <= 0) grid = 256;
    }
    if (grid < 0) return;
    (void)hipMemsetAsync((char*)d_ws + WS_CTL + 131072, 0, 16384, stream);
    Args a{};
    for (int i = 0; i < 29; ++i) a.in[i] = (const float*)d_in[i];
    a.out = (float*)d_out; a.ws = (unsigned char*)d_ws; a.ph_lo = 0; a.ph_hi = N_PHASES;
    void* kargs[] = {&a};
    hipError_t e = hipLaunchCooperativeKernel((const void*)fwd_kernel, dim3(grid), dim3(NTHREADS), kargs, LDS_BYTES, stream);
    if (e != hipSuccess) fprintf(stderr, "kernel_launch: cooperative launch failed: %s (grid %d)\n", hipGetErrorString(e), grid);
}
```
